# Optimizing an MI355X kernel written in HIP

```python
import jax, jax.numpy as jnp
from jax import lax
import numpy as np

D_MODEL = 2048
BATCH = 4
SEQ = 4096
DEPTH = 1

CHUNK = 64
PLE_DIM = 256
D_CONV = D_MODEL
CONV_WIDTH = 3
RET_HEADS = 8
RET_DK = D_MODEL // RET_HEADS
RET_DV = 2 * RET_DK
RET_QK = RET_HEADS * RET_DK
RET_V = RET_HEADS * RET_DV
D_FF = -(-8 * D_MODEL // (3 * 256)) * 256
ROPE_BASE = 10000.0
EPS = 1e-6
SPLITS = (D_CONV, D_CONV, D_CONV, RET_QK, RET_QK, RET_V, RET_V, D_MODEL, D_MODEL)
N_IN = sum(SPLITS)

kernel_name = "hybrid_shortconv_retention_block"


def rms_norm(x, g):
    xf = x.astype(jnp.float32)
    y = xf * lax.rsqrt(jnp.mean(xf * xf, axis=-1, keepdims=True) + EPS)
    return (y * g.astype(jnp.float32)).astype(x.dtype)


def rotary(t, pos):
    half = t.shape[-1] // 2
    inv = ROPE_BASE ** (-jnp.arange(half, dtype=jnp.float32) / half)
    ang = pos.astype(jnp.float32)[:, None] * inv[None, :]
    cos = jnp.cos(ang)[None, :, None, :]
    sin = jnp.sin(ang)[None, :, None, :]
    tf = t.astype(jnp.float32)
    t1, t2 = tf[..., :half], tf[..., half:]
    return jnp.concatenate([t1 * cos - t2 * sin, t2 * cos + t1 * sin], axis=-1).astype(t.dtype)


def short_conv_mixer(b, c, v, conv_w):
    u = c * v
    s = u.shape[1]
    up = jnp.pad(u, ((0, 0), (CONV_WIDTH - 1, 0), (0, 0)))
    y = conv_w[0] * up[:, 0:s]
    for tap in range(1, CONV_WIDTH):
        y = y + conv_w[tap] * up[:, tap:tap + s]
    return b * y


def retention(q, k, v):
    bsz, s = q.shape[0], q.shape[1]
    n = s // CHUNK
    log_gamma = jnp.log1p(-jnp.exp2(-5.0 - jnp.arange(RET_HEADS, dtype=jnp.float32)))
    idx = jnp.arange(CHUNK, dtype=jnp.float32)
    d_intra = jnp.exp(log_gamma[:, None, None] * jnp.abs(idx[:, None] - idx[None, :]))
    xi = jnp.exp(log_gamma[:, None] * (idx + 1.0))
    zeta = jnp.exp(log_gamma[:, None] * (CHUNK - 1.0 - idx))
    g_chunk = jnp.exp(log_gamma * CHUNK)

    def to_chunks(t):
        return t.reshape(bsz, n, CHUNK, t.shape[2], t.shape[3]).transpose(0, 3, 1, 2, 4)

    qc, kc, vc = to_chunks(q), to_chunks(k), to_chunks(v)
    scores = jnp.einsum('bhncd,bhnmd->bhncm', qc, kc) * d_intra[None, :, None]
    o_intra = jnp.einsum('bhncm,bhnme->bhnce', scores, vc)

    def step(state, inp):
        q_i, k_i, v_i = inp
        o = jnp.einsum('bhcd,bhde->bhce', q_i, state) * xi[None, :, :, None]
        state = state * g_chunk[None, :, None, None] + jnp.einsum(
            'bhcd,bhce->bhde', k_i * zeta[None, :, :, None], v_i)
        return state, o

    xs = (qc.transpose(2, 0, 1, 3, 4), kc.transpose(2, 0, 1, 3, 4), vc.transpose(2, 0, 1, 3, 4))
    state0 = jnp.zeros((bsz, RET_HEADS, q.shape[-1], v.shape[-1]), jnp.float32)
    _, o_cross = lax.scan(step, state0, xs)
    o = o_intra + o_cross.transpose(1, 2, 0, 3, 4)
    return o.transpose(0, 2, 3, 1, 4).reshape(bsz, s, RET_HEADS, v.shape[-1])


def head_group_norm(o, g, dtype):
    of = o.astype(jnp.float32)
    mu = jnp.mean(of, axis=-1, keepdims=True)
    var = jnp.mean(jnp.square(of - mu), axis=-1, keepdims=True)
    y = (of - mu) * lax.rsqrt(var + EPS)
    y = y.reshape(o.shape[0], o.shape[1], RET_V) * g.astype(jnp.float32)
    return y.astype(dtype)


def setup_inputs(seed: int = 0) -> dict:
    key = jax.random.key(seed)
    ks = jax.random.split(key, 18)
    f32 = jnp.float32

    def w(k, shape, fan_in):
        return jax.random.normal(k, shape, f32) * (fan_in ** -0.5)

    def gain(k, shape):
        return 1.0 + 0.01 * jax.random.normal(k, shape, f32)

    return {
        "x": jax.random.normal(ks[0], (BATCH, SEQ, D_MODEL), f32),
        "p": jax.random.normal(ks[1], (DEPTH, BATCH, SEQ, PLE_DIM), f32),
        "g_mix": gain(ks[2], (DEPTH, D_MODEL)),
        "w_in": w(ks[3], (DEPTH, D_MODEL, N_IN), D_MODEL),
        "conv_w": w(ks[4], (DEPTH, CONV_WIDTH, D_CONV), CONV_WIDTH),
        "w_conv_out": w(ks[5], (DEPTH, D_CONV, D_MODEL), D_CONV),
        "g_ret": gain(ks[6], (DEPTH, RET_V)),
        "w_ret_out": w(ks[7], (DEPTH, RET_V, D_MODEL), RET_V),
        "w_o": w(ks[8], (DEPTH, D_MODEL, D_MODEL), D_MODEL),
        "g_ffn": gain(ks[9], (DEPTH, D_MODEL)),
        "w_ffn_in": w(ks[10], (DEPTH, D_MODEL, 2 * D_FF), D_MODEL),
        "w_ffn_out": w(ks[11], (DEPTH, D_FF, D_MODEL), D_FF),
        "g_ple": gain(ks[12], (DEPTH, D_MODEL)),
        "w_ple_gate": w(ks[13], (DEPTH, D_MODEL, D_MODEL), D_MODEL),
        "w_ple_proj": w(ks[14], (DEPTH, PLE_DIM, D_MODEL), PLE_DIM),
        "g_final": gain(ks[15], (D_MODEL,)),
    }


def reference(x, p, g_mix, w_in, conv_w, w_conv_out, g_ret, w_ret_out, w_o,
              g_ffn, w_ffn_in, w_ffn_out, g_ple, w_ple_gate, w_ple_proj, g_final):
    bsz, s, _ = x.shape
    pos = jnp.arange(s, dtype=jnp.int32)
    split_points = np.cumsum(SPLITS)[:-1].tolist()
    for i in range(DEPTH):
        h = rms_norm(x, g_mix[i])
        proj = h @ w_in[i]
        cb, cc, cv, q, k, v, g, gate_conv, gate_ret = jnp.split(proj, split_points, axis=-1)

        y_conv = short_conv_mixer(cb, cc, cv, conv_w[i]) @ w_conv_out[i]

        q = rotary(q.reshape(bsz, s, RET_HEADS, RET_DK), pos)
        k = rotary(k.reshape(bsz, s, RET_HEADS, RET_DK), pos) * (RET_DK ** -0.5)
        o = retention(q, k, v.reshape(bsz, s, RET_HEADS, RET_DV))
        o = head_group_norm(o, g_ret[i], x.dtype)
        y_ret = (jax.nn.silu(g) * o) @ w_ret_out[i]

        merged = jax.nn.sigmoid(gate_conv) * y_conv + jax.nn.sigmoid(gate_ret) * y_ret
        x = x + merged @ w_o[i]

        h = rms_norm(x, g_ffn[i])
        a, b = jnp.split(h @ w_ffn_in[i], 2, axis=-1)
        x = x + (jax.nn.silu(a) * b) @ w_ffn_out[i]

        ple_gate = jax.nn.sigmoid(rms_norm(x, g_ple[i]) @ w_ple_gate[i])
        x = x + ple_gate * (p[i] @ w_ple_proj[i])
    return rms_norm(x, g_final)
```

```cpp
#include <hip/hip_runtime.h>
#include <hip/hip_cooperative_groups.h>
#include <cstdio>
#include <cstdint>
namespace cg = cooperative_groups;

#define LAS __attribute__((address_space(3)))
typedef unsigned short bf16_t;
typedef short bf16x8 __attribute__((ext_vector_type(8)));
typedef short s16x4 __attribute__((ext_vector_type(4)));
typedef float f32x4 __attribute__((ext_vector_type(4)));
typedef float f32x2_t __attribute__((ext_vector_type(2)));
typedef __bf16 bf16x2_t __attribute__((ext_vector_type(2)));
typedef unsigned u32x4 __attribute__((ext_vector_type(4)));
typedef unsigned u32x2 __attribute__((ext_vector_type(2)));

constexpr int M = 16384, D = 2048, SEQ = 4096, NIN = 22528, DFF = 5632, PLE = 256, RV = 4096;
constexpr float EPS = 1e-6f;
constexpr size_t MiB = 1u << 20;
constexpr size_t WS_PART1 = 0, WS_PART2 = 2 * MiB, WS_PART3 = 4 * MiB;
constexpr size_t WS_PB = 12 * MiB;
constexpr size_t WS_WINT = 20 * MiB;
constexpr size_t WS_H = 108 * MiB;
constexpr size_t WS_WCO = 20 * MiB, WS_WRO = 28 * MiB, WS_WO = 44 * MiB, WS_WFI = 52 * MiB, WS_WFO = 96 * MiB, WS_WPG = 118 * MiB, WS_WPP = 126 * MiB;
constexpr size_t WS_CB = 172 * MiB;
constexpr size_t WS_U = 236 * MiB;
constexpr size_t WS_Q = 300 * MiB, WS_K = 364 * MiB;
constexpr size_t WS_V = 428 * MiB;
constexpr size_t WS_SGR = 556 * MiB;
constexpr size_t WS_SGC = 620 * MiB;
constexpr size_t WS_END = 684 * MiB;

__device__ __forceinline__ unsigned cvtpk(float lo, float hi) { f32x2_t v = {lo, hi}; bf16x2_t b = __builtin_convertvector(v, bf16x2_t); return __builtin_bit_cast(unsigned, b); }
__device__ __forceinline__ float bflo(unsigned w) { return __uint_as_float(w << 16); }
__device__ __forceinline__ float bfhi(unsigned w) { return __uint_as_float(w & 0xffff0000u); }
__device__ __forceinline__ float sigmoidf_(float x) { return 1.0f / (1.0f + __expf(-x)); }
__device__ __forceinline__ float wave_sum(float v) {
#pragma unroll
    for (int o = 1; o < 64; o <<= 1) v += __shfl_xor(v, o);
    return v;
}

namespace pg8 {
constexpr int BM = 256, BK = 64, HALF = 128, HTB = HALF * BK * 2, STAGE_BYTES = 8 * HTB, NXCD = 8, WGM = 8;
__host__ __device__ __forceinline__ int lds_byte(int r, int c) { const int st = (r >> 4) * 2 + (c >> 5), rr = r & 15, cc = c & 31, ob = rr * 64 + cc * 2; return st * 1024 + (ob ^ (((ob >> 9) & 1) << 5)); }
__host__ __device__ __forceinline__ void stage_rc(int b, int& R, int& C) { const int st = b / 1024, sb = b % 1024, swz = sb ^ (((sb >> 9) & 1) << 5); R = (st >> 1) * 16 + swz / 64; C = (st & 1) * 32 + (swz % 64) / 2; }
__host__ __device__ __forceinline__ int perm32(int rho) { const int n = rho >> 4, i = rho & 15; return 8 * (i >> 2) + 4 * n + (i & 3); }

struct Unit { int pm, pn; };
struct Gemm { const bf16_t* A; const bf16_t* Bt; int M, N, K; };

struct StaticOrder {
    int nM, nN, nwg, G, c;
    __host__ __device__ void init(int M_, int N_, int G_, int c_) { nM = M_ / BM; nN = N_ / BM; nwg = nM * nN; G = G_; c = c_; }
    __host__ __device__ bool next(int i, Unit& u) const {
        const long L = (long)i * G + c; if (L >= nwg) return false;
        int wgid = (int)L; { const int q = nwg / NXCD, r = nwg % NXCD, xcd = wgid % NXCD, off = wgid / NXCD; wgid = (xcd < r ? xcd * (q + 1) : r * (q + 1) + (xcd - r) * q) + off; }
        const int nig = WGM * nN, gid = wgid / nig, fm = gid * WGM, gsz = (nM - fm) < WGM ? (nM - fm) : WGM;
        u.pm = fm + ((wgid % nig) % gsz); u.pn = (wgid % nig) / gsz; return true;
    }
};

template <class Epi, class Sched>
__device__ __forceinline__ void gemm_phase(LAS unsigned char* lds, const Gemm g, const Sched& S, const Epi& E) {
    int tid_ = threadIdx.x; asm volatile("" : "+v"(tid_));
    const int tid = tid_, wid = __builtin_amdgcn_readfirstlane(tid >> 6), lane = tid & 63, wr = wid >> 2, wc = wid & 3, fr = lane & 15, fq = lane >> 4;
    int K_ = g.K; asm volatile("" : "+s"(K_));
    const int K = K_, nt = K / BK;
    unsigned voffA[2], voffB[2];
#pragma unroll
    for (int i = 0; i < 2; ++i) { int R, C; stage_rc(tid * 16 + i * 8192, R, C); const int Rb = (R & ~31) + perm32(R & 31);
        voffA[i] = (unsigned)(R * K + C) * 2u; voffB[i] = (unsigned)(Rb * K + C) * 2u; }
    const size_t kstep = (size_t)(BK * 2);
    const size_t hstep = (size_t)HALF * K * 2;
    const size_t tstep = 2 * hstep;
    const unsigned ldsw = (unsigned)wid * 1024u;
    const int aoff = lds_byte(wr * 64 + fr, fq * 8), boff = lds_byte(wc * 32 + fr, fq * 8);
#define PG8_SA(b, h) (((b) * 2 + (h)) * HTB)
#define PG8_SB(b, h) ((4 + (b) * 2 + (h)) * HTB)
#define PG8_STAGE(bufoff, gbase, voff) do { _Pragma("unroll") for (int _i = 0; _i < 2; ++_i) \
        __builtin_amdgcn_global_load_lds((const unsigned*)((const char*)(gbase) + (voff)[_i]), (LAS unsigned*)(lds + (bufoff) + ldsw + _i * 8192), 16, 0, 0); } while (0)
#define PG8_LDA(dst, b, h) do { _Pragma("unroll") for (int m = 0; m < 4; ++m) _Pragma("unroll") for (int k = 0; k < 2; ++k) dst[m][k] = *(const LAS bf16x8*)(lds + PG8_SA(b, h) + aoff + m * 2048 + k * 1024); } while (0)
#define PG8_LDB(dst, b, h) do { _Pragma("unroll") for (int n = 0; n < 2; ++n) _Pragma("unroll") for (int k = 0; k < 2; ++k) dst[n][k] = *(const LAS bf16x8*)(lds + PG8_SB(b, h) + boff + n * 2048 + k * 1024); } while (0)
#define PG8_MMA(ai, bj, At, Bt) do { __builtin_amdgcn_s_setprio(1); _Pragma("unroll") for (int m = 0; m < 4; ++m) _Pragma("unroll") for (int n = 0; n < 2; ++n) _Pragma("unroll") for (int k = 0; k < 2; ++k) \
        acc[ai][bj][m][n] = __builtin_amdgcn_mfma_f32_16x16x32_bf16(Bt[n][k], At[m][k], acc[ai][bj][m][n], 0, 0, 0); __builtin_amdgcn_s_setprio(0); } while (0)
#define PG8_WAIT_V(n) asm volatile("s_waitcnt vmcnt(" #n ")" ::: "memory")
#define PG8_WAIT_L(n) asm volatile("s_waitcnt lgkmcnt(" #n ")" ::: "memory")
#define PG8_BAR __builtin_amdgcn_s_barrier()
#define PG8_SCHED __builtin_amdgcn_sched_barrier(0)
    Unit cur, nxt; int ui = 0;
    if (!S.next(0, cur)) return;
    f32x4 acc[2][2][4][2];
#pragma unroll
    for (int a = 0; a < 2; ++a)
#pragma unroll
        for (int b = 0; b < 2; ++b)
#pragma unroll
            for (int m = 0; m < 4; ++m)
#pragma unroll
                for (int n = 0; n < 2; ++n) acc[a][b][m][n] = (f32x4){0.f, 0.f, 0.f, 0.f};
    bf16x8 At[4][2], B0[2][2], B1[2][2];
    const char* cA = (const char*)g.A + (size_t)cur.pm * tstep; const char* cB = (const char*)g.Bt + (size_t)cur.pn * tstep;
    PG8_STAGE(PG8_SB(0, 0), cB, voffB); PG8_STAGE(PG8_SB(0, 1), cB + hstep, voffB); PG8_STAGE(PG8_SA(0, 0), cA, voffA); PG8_STAGE(PG8_SA(0, 1), cA + hstep, voffA);
    if (wr == 1) PG8_BAR;
    PG8_WAIT_V(2); PG8_BAR;
    PG8_STAGE(PG8_SB(1, 0), cB + kstep, voffB); PG8_STAGE(PG8_SA(1, 0), cA + kstep, voffA); PG8_STAGE(PG8_SB(1, 1), cB + hstep + kstep, voffB);
    PG8_WAIT_V(6); PG8_BAR;
    for (;;) {
        const bool has_next = S.next(ui + 1, nxt);
        const char* nA = has_next ? (const char*)g.A + (size_t)nxt.pm * tstep : cA; const char* nB = has_next ? (const char*)g.Bt + (size_t)nxt.pn * tstep : cB;
        for (int t = 0; t < nt; t += 2) {
            const bool last = (t == nt - 2);
            const char* a1 = cA + (size_t)(t + 1) * kstep;
            const char* a2 = last ? nA : cA + (size_t)(t + 2) * kstep; const char* b2 = last ? nB : cB + (size_t)(t + 2) * kstep;
            const char* a3 = a2 + kstep; const char* b3 = b2 + kstep;
            PG8_LDB(B0, 0, 0); PG8_LDB(B1, 0, 1); PG8_SCHED; PG8_LDA(At, 0, 0); PG8_STAGE(PG8_SA(1, 1), a1 + hstep, voffA);
            PG8_WAIT_V(8); PG8_WAIT_L(0); PG8_BAR; PG8_MMA(0, 0, At, B0); PG8_MMA(0, 1, At, B1); PG8_BAR; PG8_SCHED;
            PG8_LDA(At, 0, 1); PG8_STAGE(PG8_SB(0, 0), b2, voffB); PG8_STAGE(PG8_SB(0, 1), b2 + hstep, voffB); PG8_STAGE(PG8_SA(0, 0), a2, voffA);
            PG8_WAIT_V(8); PG8_WAIT_L(0); PG8_BAR; PG8_MMA(1, 0, At, B0); PG8_MMA(1, 1, At, B1); PG8_BAR; PG8_SCHED;
            PG8_LDB(B0, 1, 0); PG8_LDB(B1, 1, 1); PG8_SCHED; PG8_LDA(At, 1, 0); PG8_STAGE(PG8_SA(0, 1), a2 + hstep, voffA);
            PG8_WAIT_V(8); PG8_WAIT_L(0); PG8_BAR; PG8_MMA(0, 0, At, B0); PG8_MMA(0, 1, At, B1); PG8_BAR; PG8_SCHED;
            PG8_LDA(At, 1, 1); PG8_STAGE(PG8_SB(1, 0), b3, voffB); PG8_STAGE(PG8_SB(1, 1), b3 + hstep, voffB); PG8_STAGE(PG8_SA(1, 0), a3, voffA);
            PG8_WAIT_V(8); PG8_WAIT_L(0); PG8_BAR; PG8_MMA(1, 0, At, B0); PG8_MMA(1, 1, At, B1); PG8_BAR; PG8_SCHED;
        }
        if (wr == 0) PG8_BAR;
        E(acc, cur, wr, wc, fr, fq);
        if (!has_next) break;
#pragma unroll
        for (int a = 0; a < 2; ++a)
#pragma unroll
            for (int b = 0; b < 2; ++b)
#pragma unroll
                for (int m = 0; m < 4; ++m)
#pragma unroll
                    for (int n = 0; n < 2; ++n) acc[a][b][m][n] = (f32x4){0.f, 0.f, 0.f, 0.f};
        cur = nxt; cA = nA; cB = nB; ++ui;
        if (wr == 1) PG8_BAR;
    }
    PG8_WAIT_V(0);
    PG8_BAR;
#undef PG8_SA
#undef PG8_SB
#undef PG8_STAGE
#undef PG8_LDA
#undef PG8_LDB
#undef PG8_MMA
#undef PG8_WAIT_V
#undef PG8_WAIT_L
#undef PG8_BAR
#undef PG8_SCHED
}
}

typedef f32x4 Acc[2][2][4][2];

__device__ __forceinline__ float row_rstd(const float* part, int row, int fq) {
    const f32x4* p = (const f32x4*)(part + (size_t)row * 32 + fq * 8);
    const f32x4 a = p[0], b = p[1];
    float s = ((a.x + a.y) + (a.z + a.w)) + ((b.x + b.y) + (b.z + b.w));
    s += __shfl_xor(s, 16); s += __shfl_xor(s, 32);
    return rsqrtf(s * (1.0f / D) + EPS);
}
__device__ __forceinline__ u32x4 pack8(const f32x4 a, const f32x4 b) { u32x4 w; w.x = cvtpk(a[0], a[1]); w.y = cvtpk(a[2], a[3]); w.z = cvtpk(b[0], b[1]); w.w = cvtpk(b[2], b[3]); return w; }
__device__ __forceinline__ void unpack8(const u32x4 w, f32x4& a, f32x4& b) { a = (f32x4){bflo(w.x), bfhi(w.x), bflo(w.y), bfhi(w.y)}; b = (f32x4){bflo(w.z), bfhi(w.z), bflo(w.w), bfhi(w.w)}; }

struct EpiInProj {
    bf16_t *cb, *u, *q, *k, *v, *sg, *sgc, *sgr;
    __device__ __forceinline__ void operator()(const Acc& acc, const pg8::Unit& un, int wr, int wc, int fr, int fq) const {
        const int pn = un.pn, row0 = un.pm * 256 + wr * 64 + fr, lc = wc * 32 + 8 * fq;
        if (pn >= 8 && pn < 24) {
            bf16_t* base = u + (size_t)(pn - 8) * 128 + lc;
#pragma unroll
            for (int ai = 0; ai < 2; ++ai)
#pragma unroll
                for (int m = 0; m < 4; ++m) { const f32x4 a = acc[ai][0][m][0] * acc[ai][1][m][0], b = acc[ai][0][m][1] * acc[ai][1][m][1];
                    *(u32x4*)(base + (size_t)(row0 + ai * 128 + m * 16) * D) = pack8(a, b); }
        } else if (pn >= 24 && pn < 40) {
            const bool isk = pn >= 32; const int head = (pn - 24) & 7; const float sc = isk ? 0.0625f : 1.0f;
            bf16_t* base = (isk ? k : q) + head * 256 + lc;
            float cj[8];
#pragma unroll
            for (int e = 0; e < 8; ++e) cj[e] = exp2f(-(float)(lc + e) * (13.287712379549449f / 128.0f)) * 0.15915494309189535f;
#pragma unroll
            for (int ai = 0; ai < 2; ++ai)
#pragma unroll
                for (int m = 0; m < 4; ++m) {
                    const int row = row0 + ai * 128 + m * 16; const float pos = (float)(row & (SEQ - 1));
                    f32x4 o1[2], o2[2];
#pragma unroll
                    for (int n = 0; n < 2; ++n)
#pragma unroll
                        for (int e = 0; e < 4; ++e) {
                            float r = pos * cj[n * 4 + e]; r = r - floorf(r);
                            const float sn = __builtin_amdgcn_sinf(r), cs = __builtin_amdgcn_cosf(r);
                            const float t1 = acc[ai][0][m][n][e], t2 = acc[ai][1][m][n][e];
                            o1[n][e] = (t1 * cs - t2 * sn) * sc; o2[n][e] = (t2 * cs + t1 * sn) * sc;
                        }
                    bf16_t* rp = base + (size_t)row * D;
                    *(u32x4*)rp = pack8(o1[0], o1[1]); *(u32x4*)(rp + 128) = pack8(o2[0], o2[1]);
                }
        } else {
            bf16_t* base; int ld, act;
            if (pn < 8) { base = cb + pn * 256; ld = D; act = 0; }
            else if (pn < 56) { base = v + (pn - 40) * 256; ld = RV; act = 0; }
            else if (pn < 72) { base = sg + (pn - 56) * 256; ld = RV; act = 1; }
            else if (pn < 80) { base = sgc + (pn - 72) * 256; ld = D; act = 2; }
            else { base = sgr + (pn - 80) * 256; ld = D; act = 2; }
            base += lc;
#pragma unroll
            for (int ai = 0; ai < 2; ++ai)
#pragma unroll
                for (int m = 0; m < 4; ++m) { bf16_t* rp = base + (size_t)(row0 + ai * 128 + m * 16) * ld;
#pragma unroll
                    for (int bj = 0; bj < 2; ++bj) { f32x4 a = acc[ai][bj][m][0], b = acc[ai][bj][m][1];
                        if (act) {
#pragma unroll
                            for (int e = 0; e < 4; ++e) { const float sa = sigmoidf_(a[e]), sb = sigmoidf_(b[e]); a[e] = act == 1 ? a[e] * sa : sa; b[e] = act == 1 ? b[e] * sb : sb; } }
                        *(u32x4*)(rp + bj * 128) = pack8(a, b); } }
        }
    }
};

struct EpiGate {
    const bf16_t* T; const bf16_t* G; bf16_t* O;
    __device__ __forceinline__ void operator()(const Acc& acc, const pg8::Unit& un, int wr, int wc, int fr, int fq) const {
        const int row0 = un.pm * 256 + wr * 64 + fr; const size_t col0 = (size_t)un.pn * 256 + wc * 32 + 8 * fq;
#pragma unroll
        for (int ai = 0; ai < 2; ++ai)
#pragma unroll
            for (int m = 0; m < 4; ++m) { const size_t off = (size_t)(row0 + ai * 128 + m * 16) * D + col0;
#pragma unroll
                for (int bj = 0; bj < 2; ++bj) { f32x4 ga, gb; unpack8(*(const u32x4*)(G + off + bj * 128), ga, gb);
                    f32x4 a = ga * acc[ai][bj][m][0], b = gb * acc[ai][bj][m][1];
                    if (T) { f32x4 ta, tb; unpack8(*(const u32x4*)(T + off + bj * 128), ta, tb); a += ta; b += tb; }
                    *(u32x4*)(O + off + bj * 128) = pack8(a, b); } }
    }
};

struct EpiRes {
    const float* xin; float* xout; bf16_t* xb; float* part;
    __device__ __forceinline__ void operator()(const Acc& acc, const pg8::Unit& un, int wr, int wc, int fr, int fq) const {
        const int row0 = un.pm * 256 + wr * 64 + fr; const size_t col0 = (size_t)un.pn * 256 + wc * 32 + 8 * fq;
#pragma unroll
        for (int ai = 0; ai < 2; ++ai)
#pragma unroll
            for (int m = 0; m < 4; ++m) { const int row = row0 + ai * 128 + m * 16; const size_t off = (size_t)row * D + col0; float ss = 0.f;
#pragma unroll
                for (int bj = 0; bj < 2; ++bj) {
                    const f32x4 a = *(const f32x4*)(xin + off + bj * 128) + acc[ai][bj][m][0], b = *(const f32x4*)(xin + off + bj * 128 + 4) + acc[ai][bj][m][1];
                    *(f32x4*)(xout + off + bj * 128) = a; *(f32x4*)(xout + off + bj * 128 + 4) = b;
                    *(u32x4*)(xb + off + bj * 128) = pack8(a, b);
                    ss += ((a[0] * a[0] + a[1] * a[1]) + (a[2] * a[2] + a[3] * a[3])) + ((b[0] * b[0] + b[1] * b[1]) + (b[2] * b[2] + b[3] * b[3])); }
                ss += __shfl_xor(ss, 16); ss += __shfl_xor(ss, 32);
                if (fq == 0) part[(size_t)row * 32 + un.pn * 4 + wc] = ss; }
    }
};

struct EpiFfnIn {
    const float* part; bf16_t* hid;
    __device__ __forceinline__ void operator()(const Acc& acc, const pg8::Unit& un, int wr, int wc, int fr, int fq) const {
        const int row0 = un.pm * 256 + wr * 64 + fr; const size_t col0 = (size_t)un.pn * 128 + wc * 32 + 8 * fq;
#pragma unroll
        for (int ai = 0; ai < 2; ++ai)
#pragma unroll
            for (int m = 0; m < 4; ++m) { const int row = row0 + ai * 128 + m * 16; const float rs = row_rstd(part, row, fq);
                f32x4 o[2];
#pragma unroll
                for (int n = 0; n < 2; ++n)
#pragma unroll
                    for (int e = 0; e < 4; ++e) { const float a = rs * acc[ai][0][m][n][e], b = rs * acc[ai][1][m][n][e]; o[n][e] = a * sigmoidf_(a) * b; }
                *(u32x4*)(hid + (size_t)row * DFF + col0) = pack8(o[0], o[1]); }
    }
};

struct EpiPlain {
    bf16_t* O;
    __device__ __forceinline__ void operator()(const Acc& acc, const pg8::Unit& un, int wr, int wc, int fr, int fq) const {
        const int row0 = un.pm * 256 + wr * 64 + fr; const size_t col0 = (size_t)un.pn * 256 + wc * 32 + 8 * fq;
#pragma unroll
        for (int ai = 0; ai < 2; ++ai)
#pragma unroll
            for (int m = 0; m < 4; ++m) { const size_t off = (size_t)(row0 + ai * 128 + m * 16) * D + col0;
#pragma unroll
                for (int bj = 0; bj < 2; ++bj) *(u32x4*)(O + off + bj * 128) = pack8(acc[ai][bj][m][0], acc[ai][bj][m][1]); }
    }
};

struct EpiPle {
    const float* part_in; const float* xin; const bf16_t* pp; float* xout; float* part;
    __device__ __forceinline__ void operator()(const Acc& acc, const pg8::Unit& un, int wr, int wc, int fr, int fq) const {
        const int row0 = un.pm * 256 + wr * 64 + fr; const size_t col0 = (size_t)un.pn * 256 + wc * 32 + 8 * fq;
#pragma unroll
        for (int ai = 0; ai < 2; ++ai)
#pragma unroll
            for (int m = 0; m < 4; ++m) { const int row = row0 + ai * 128 + m * 16; const size_t off = (size_t)row * D + col0; float ss = 0.f;
                const float rs = row_rstd(part_in, row, fq);
#pragma unroll
                for (int bj = 0; bj < 2; ++bj) { f32x4 pa, pb; unpack8(*(const u32x4*)(pp + off + bj * 128), pa, pb);
                    f32x4 a = *(const f32x4*)(xin + off + bj * 128), b = *(const f32x4*)(xin + off + bj * 128 + 4);
#pragma unroll
                    for (int e = 0; e < 4; ++e) { a[e] += sigmoidf_(rs * acc[ai][bj][m][0][e]) * pa[e]; b[e] += sigmoidf_(rs * acc[ai][bj][m][1][e]) * pb[e]; }
                    *(f32x4*)(xout + off + bj * 128) = a; *(f32x4*)(xout + off + bj * 128 + 4) = b;
                    ss += ((a[0] * a[0] + a[1] * a[1]) + (a[2] * a[2] + a[3] * a[3])) + ((b[0] * b[0] + b[1] * b[1]) + (b[2] * b[2] + b[3] * b[3])); }
                ss += __shfl_xor(ss, 16); ss += __shfl_xor(ss, 32);
                if (fq == 0) part[(size_t)row * 32 + un.pn * 4 + wc] = ss; }
    }
};

__device__ __forceinline__ void transpose_item(const float* W, int K, int N, bf16_t* WT, int drow0, int k0, int n0, const float* gk, LAS float* scr, int lane) {
#pragma unroll 8
    for (int i = 0; i < 32; ++i) { const int kk = 2 * i + (lane >> 5); float w = W[(size_t)(k0 + kk) * N + n0 + (lane & 31)]; if (gk) w *= gk[k0 + kk]; scr[kk * 33 + (lane & 31)] = w; }
    asm volatile("s_waitcnt lgkmcnt(0)" ::: "memory");
    const int c = lane & 7;
#pragma unroll
    for (int j = 0; j < 4; ++j) { const int n = (lane >> 3) + 8 * j; const LAS float* s = scr + (8 * c) * 33 + n;
        u32x4 o; o.x = cvtpk(s[0 * 33], s[1 * 33]); o.y = cvtpk(s[2 * 33], s[3 * 33]); o.z = cvtpk(s[4 * 33], s[5 * 33]); o.w = cvtpk(s[6 * 33], s[7 * 33]);
        *(u32x4*)(WT + (size_t)(drow0 + n) * K + k0 + 8 * c) = o; }
    asm volatile("s_waitcnt lgkmcnt(0)" ::: "memory");
}
template <int MODE>
__device__ __forceinline__ void transpose_matrix_item(const float* W, int K, int N, bf16_t* WT, const float* gk, int item, LAS float* scr, int lane) {
    const int nblk = N / 32, kb = item / nblk, nb = item % nblk, n0 = nb * 32; int drow0 = n0;
    if (MODE == 1) { if (n0 >= 2048 && n0 < 4096) { const int c = n0 - 2048; drow0 = 2048 + (c >> 7) * 256 + (c & 127); } else if (n0 >= 4096 && n0 < 6144) { const int c = n0 - 4096; drow0 = 2048 + (c >> 7) * 256 + 128 + (c & 127); } }
    if (MODE == 2) { if (n0 < DFF) drow0 = (n0 >> 7) * 256 + (n0 & 127); else { const int c = n0 - DFF; drow0 = (c >> 7) * 256 + 128 + (c & 127); } }
    transpose_item(W, K, N, WT, drow0, kb * 64, n0, gk, scr, lane);
}

typedef short v4i16_t __attribute__((ext_vector_type(4)));
__device__ __forceinline__ bf16x8 tr_read8(const LAS unsigned char* p, int rowstride4  ) {
    const v4i16_t a = __builtin_amdgcn_ds_read_tr16_b64_v4i16((LAS v4i16_t*)p);
    const v4i16_t b = __builtin_amdgcn_ds_read_tr16_b64_v4i16((LAS v4i16_t*)(p + rowstride4));
    return __builtin_shufflevector(a, b, 0, 1, 2, 3, 4, 5, 6, 7);
}

__device__ __forceinline__ void retention_item(LAS unsigned char* lds, const bf16_t* Qg, const bf16_t* Kg, bf16_t* Vg, int item) {
    constexpr int QP = 264, VP = 72;
    constexpr int QS = 0, KS = 33792, ST = 67584, VS = 101376, VZ = 110592, SS = 119808;
    int tid_ = threadIdx.x; asm volatile("" : "+v"(tid_));
    const int tid = tid_, lane = tid & 63, w = __builtin_amdgcn_readfirstlane(tid >> 6);
    const int b = item >> 6, h = (item >> 3) & 7, es = item & 7;
    const int l15 = lane & 15, g = lane >> 4, tq = (lane >> 2) & 3, tp = lane & 3;
    const float xg = exp2f(-5.0f - (float)h);
    const float lng = -xg * (1.0f + xg * (0.5f + xg * (1.0f / 3.0f + xg * (0.25f + xg * (0.2f + xg * (1.0f / 6.0f))))));
    const float l2g = lng * 1.4426950408889634f;
    const float gchunk = exp2f(l2g * 64.0f);
    for (int i = tid; i < 33792 / 16; i += 512) *(LAS u32x4*)(lds + ST + i * 16) = (u32x4){0u, 0u, 0u, 0u};
    f32x4 accT[2][4];
#pragma unroll
    for (int a = 0; a < 2; ++a)
#pragma unroll
        for (int e = 0; e < 4; ++e) accT[a][e] = (f32x4){0.f, 0.f, 0.f, 0.f};
    const int vrow = tid >> 3, vch = tid & 7;
    const float zeta = exp2f(l2g * (float)(63 - vrow));
    const size_t rowbase0 = (size_t)b * SEQ;
    u32x4 qreg[4], kreg[4], vreg;
#define RET_LOAD(i_) do { const size_t rb_ = rowbase0 + (size_t)(i_) * 64; \
        _Pragma("unroll") for (int j = 0; j < 4; ++j) { const int idx = tid + 512 * j, row = idx >> 5, ch = idx & 31; \
            qreg[j] = *(const u32x4*)(Qg + (rb_ + row) * D + h * 256 + ch * 8); kreg[j] = *(const u32x4*)(Kg + (rb_ + row) * D + h * 256 + ch * 8); } \
        vreg = *(const u32x4*)(Vg + (rb_ + vrow) * RV + h * 512 + es * 64 + vch * 8); } while (0)
    RET_LOAD(0);
    const int tr = w >> 1, tc0 = 2 * (w & 1);
    for (int i = 0; i < 64; ++i) {
#pragma unroll
        for (int j = 0; j < 4; ++j) { const int idx = tid + 512 * j, row = idx >> 5, ch = idx & 31;
            *(LAS u32x4*)(lds + QS + (row * QP + ch * 8) * 2) = qreg[j]; *(LAS u32x4*)(lds + KS + (row * QP + ch * 8) * 2) = kreg[j]; }
        { *(LAS u32x4*)(lds + VS + (vrow * VP + vch * 8) * 2) = vreg;
          f32x4 a, bb; unpack8(vreg, a, bb); a = a * zeta; bb = bb * zeta; *(LAS u32x4*)(lds + VZ + (vrow * VP + vch * 8) * 2) = pack8(a, bb); }
        if (i < 63) RET_LOAD(i + 1);
        __syncthreads();
        f32x4 accS[2], accC[2];
#pragma unroll
        for (int t = 0; t < 2; ++t) { accS[t] = (f32x4){0.f, 0.f, 0.f, 0.f}; accC[t] = (f32x4){0.f, 0.f, 0.f, 0.f}; }
#pragma unroll
        for (int kk = 0; kk < 8; ++kk) {
            const int dof = (kk * 32 + 8 * g) * 2;
            const bf16x8 qf = *(const LAS bf16x8*)(lds + QS + (tr * 16 + l15) * (QP * 2) + dof);
#pragma unroll
            for (int t = 0; t < 2; ++t) {
                const bf16x8 kf = *(const LAS bf16x8*)(lds + KS + ((tc0 + t) * 16 + l15) * (QP * 2) + dof);
                accS[t] = __builtin_amdgcn_mfma_f32_16x16x32_bf16(kf, qf, accS[t], 0, 0, 0);
                const bf16x8 sf = *(const LAS bf16x8*)(lds + ST + ((tc0 + t) * 16 + l15) * (QP * 2) + dof);
                accC[t] = __builtin_amdgcn_mfma_f32_16x16x32_bf16(sf, qf, accC[t], 0, 0, 0);
            }
        }
        const int crow = tr * 16 + l15;
#pragma unroll
        for (int t = 0; t < 2; ++t) { const int m0 = (tc0 + t) * 16 + 4 * g; f32x4 sv;
#pragma unroll
            for (int e = 0; e < 4; ++e) { const int dd = crow - (m0 + e); sv[e] = accS[t][e] * exp2f(l2g * (float)(dd < 0 ? -dd : dd)); }
            u32x2 pk; pk.x = cvtpk(sv[0], sv[1]); pk.y = cvtpk(sv[2], sv[3]);
            *(LAS u32x2*)(lds + SS + (crow * VP + m0) * 2) = pk; }
        __syncthreads();
        f32x4 accI[2];
#pragma unroll
        for (int t = 0; t < 2; ++t) accI[t] = (f32x4){0.f, 0.f, 0.f, 0.f};
#pragma unroll
        for (int ks = 0; ks < 2; ++ks) {
            const bf16x8 sfr = *(const LAS bf16x8*)(lds + SS + (crow * VP + ks * 32 + 8 * g) * 2);
#pragma unroll
            for (int t = 0; t < 2; ++t) {
                const bf16x8 vf = tr_read8(lds + VS + ((ks * 32 + 8 * g + tq) * VP + (tc0 + t) * 16 + 4 * tp) * 2, 4 * VP * 2);
                accI[t] = __builtin_amdgcn_mfma_f32_16x16x32_bf16(vf, sfr, accI[t], 0, 0, 0);
            }
        }
        { const float xi = exp2f(l2g * (float)(crow + 1)); const size_t rb = rowbase0 + (size_t)i * 64;
#pragma unroll
          for (int t = 0; t < 2; ++t) { const f32x4 o = accI[t] + accC[t] * xi; u32x2 pk; pk.x = cvtpk(o[0], o[1]); pk.y = cvtpk(o[2], o[3]);
              *(u32x2*)(Vg + (rb + crow) * RV + h * 512 + es * 64 + (tc0 + t) * 16 + 4 * g) = pk; } }
#pragma unroll
        for (int a = 0; a < 2; ++a)
#pragma unroll
            for (int e = 0; e < 4; ++e) accT[a][e] = accT[a][e] * gchunk;
#pragma unroll
        for (int ks = 0; ks < 2; ++ks) {
            bf16x8 kfr[2], vzf[4];
#pragma unroll
            for (int a = 0; a < 2; ++a) kfr[a] = tr_read8(lds + KS + ((ks * 32 + 8 * g + tq) * QP + (2 * w + a) * 16 + 4 * tp) * 2, 4 * QP * 2);
#pragma unroll
            for (int e = 0; e < 4; ++e) vzf[e] = tr_read8(lds + VZ + ((ks * 32 + 8 * g + tq) * VP + e * 16 + 4 * tp) * 2, 4 * VP * 2);
#pragma unroll
            for (int a = 0; a < 2; ++a)
#pragma unroll
                for (int e = 0; e < 4; ++e) accT[a][e] = __builtin_amdgcn_mfma_f32_16x16x32_bf16(kfr[a], vzf[e], accT[a][e], 0, 0, 0);
        }
#pragma unroll
        for (int a = 0; a < 2; ++a)
#pragma unroll
            for (int e = 0; e < 4; ++e) { u32x2 pk; pk.x = cvtpk(accT[a][e][0], accT[a][e][1]); pk.y = cvtpk(accT[a][e][2], accT[a][e][3]);
                *(LAS u32x2*)(lds + ST + ((e * 16 + l15) * QP + (2 * w + a) * 16 + 4 * g) * 2) = pk; }
        __syncthreads();
    }
#undef RET_LOAD
}

struct Args { const float* in[16]; float* out; unsigned char* ws; };
constexpr int LDS_BYTES = 147456;

__global__ void __launch_bounds__(512, 2) mega(Args a) {
    extern __shared__ __attribute__((aligned(16))) unsigned char lds_raw[];
    LAS unsigned char* lds = (LAS unsigned char*)lds_raw;
    cg::grid_group grid = cg::this_grid();
    const int tid = threadIdx.x, lane = tid & 63, wave = __builtin_amdgcn_readfirstlane(tid >> 6);
    const int G = gridDim.x, bx = blockIdx.x;
    const int gw = bx * 8 + wave, NGW = G * 8;
    unsigned char* ws = a.ws;
    const float* x = a.in[0]; const float* p = a.in[1]; const float* g_mix = a.in[2]; const float* w_in = a.in[3]; const float* conv_w = a.in[4];
    const float* w_conv_out = a.in[5]; const float* g_ret = a.in[6]; const float* w_ret_out = a.in[7]; const float* w_o = a.in[8]; const float* g_ffn = a.in[9];
    const float* w_ffn_in = a.in[10]; const float* w_ffn_out = a.in[11]; const float* g_ple = a.in[12]; const float* w_ple_gate = a.in[13]; const float* w_ple_proj = a.in[14];
    const float* g_final = a.in[15];
    float* part1 = (float*)(ws + WS_PART1); float* part2 = (float*)(ws + WS_PART2); float* part3 = (float*)(ws + WS_PART3);
    bf16_t* pb = (bf16_t*)(ws + WS_PB); bf16_t* WinT = (bf16_t*)(ws + WS_WINT); bf16_t* hb = (bf16_t*)(ws + WS_H);
    bf16_t* WcoT = (bf16_t*)(ws + WS_WCO); bf16_t* WroT = (bf16_t*)(ws + WS_WRO); bf16_t* WoT = (bf16_t*)(ws + WS_WO); bf16_t* WfiT = (bf16_t*)(ws + WS_WFI);
    bf16_t* WfoT = (bf16_t*)(ws + WS_WFO); bf16_t* WpgT = (bf16_t*)(ws + WS_WPG); bf16_t* WppT = (bf16_t*)(ws + WS_WPP);
    bf16_t* cb = (bf16_t*)(ws + WS_CB); bf16_t* ub = (bf16_t*)(ws + WS_U); bf16_t* qb = (bf16_t*)(ws + WS_Q); bf16_t* kb = (bf16_t*)(ws + WS_K);
    bf16_t* vb = (bf16_t*)(ws + WS_V); bf16_t* sgr = (bf16_t*)(ws + WS_SGR); bf16_t* sgc = (bf16_t*)(ws + WS_SGC);
    bf16_t* sg = (bf16_t*)a.out;
    float* x1 = (float*)(ws + WS_Q); bf16_t* x1b = ub; bf16_t* hid = vb; bf16_t* x2b = cb; bf16_t* ppb = sgc;
    LAS float* scr = (LAS float*)(lds + wave * 16384);

#ifndef PHMASK
#define PHMASK 0xFFFF
#endif
    for (int it = gw; it < (D / 64) * (NIN / 32); it += NGW) transpose_matrix_item<1>(w_in, D, NIN, WinT, nullptr, it, scr, lane);
    for (int m = gw; m < M; m += NGW) {
        const f32x4* xr = (const f32x4*)(x + (size_t)m * D) + lane; const f32x4* gr = (const f32x4*)g_mix + lane;
        f32x4 v[8]; float s = 0.f;
#pragma unroll
        for (int j = 0; j < 8; ++j) { v[j] = xr[64 * j]; s += (v[j].x * v[j].x + v[j].y * v[j].y) + (v[j].z * v[j].z + v[j].w * v[j].w); }
        const float rs = rsqrtf(wave_sum(s) * (1.0f / D) + EPS);
        u32x2* o8 = (u32x2*)(hb + (size_t)m * D) + lane;
#pragma unroll
        for (int j = 0; j < 8; ++j) { const f32x4 gg = gr[64 * j]; u32x2 pk; pk.x = cvtpk(v[j].x * rs * gg.x, v[j].y * rs * gg.y); pk.y = cvtpk(v[j].z * rs * gg.z, v[j].w * rs * gg.w); o8[64 * j] = pk; }
    }
    for (size_t i = (size_t)bx * 512 + tid; i < (size_t)M * PLE / 8; i += (size_t)G * 512) {
        const f32x4 a0 = ((const f32x4*)p)[2 * i], a1 = ((const f32x4*)p)[2 * i + 1]; ((u32x4*)pb)[i] = pack8(a0, a1); }
    grid.sync();

    if (PHMASK & 2) { pg8::Gemm g{hb, WinT, M, NIN, D}; pg8::StaticOrder S; S.init(M, NIN, G, bx);
      EpiInProj E{cb, ub, qb, kb, vb, sg, sgc, sgr};
      pg8::gemm_phase(lds, g, S, E); }
    grid.sync();

    if (PHMASK & 4) for (int item = bx; item < 256; item += G) { retention_item(lds, qb, kb, vb, item); }
    grid.sync();

    for (int strip = bx; strip < M / 32; strip += G) {
        const int cgp = tid & 255, rh = tid >> 8, r0 = strip * 32 + rh * 16, c0 = cgp * 8;
        f32x4 w0a = *(const f32x4*)(conv_w + c0), w0b = *(const f32x4*)(conv_w + c0 + 4), w1a = *(const f32x4*)(conv_w + D + c0), w1b = *(const f32x4*)(conv_w + D + c0 + 4),
              w2a = *(const f32x4*)(conv_w + 2 * D + c0), w2b = *(const f32x4*)(conv_w + 2 * D + c0 + 4);
        f32x4 p2a = {0.f, 0.f, 0.f, 0.f}, p2b = p2a, p1a = p2a, p1b = p2a;
        const int s0 = r0 & (SEQ - 1);
        if (s0 >= 2) { unpack8(*(const u32x4*)(ub + (size_t)(r0 - 2) * D + c0), p2a, p2b); unpack8(*(const u32x4*)(ub + (size_t)(r0 - 1) * D + c0), p1a, p1b); }
#pragma unroll 4
        for (int i = 0; i < 16; ++i) { const size_t off = (size_t)(r0 + i) * D + c0; f32x4 ua, ubv, ca, cbv; unpack8(*(const u32x4*)(ub + off), ua, ubv); unpack8(*(const u32x4*)(cb + off), ca, cbv);
            const f32x4 ya = ca * (w0a * p2a + w1a * p1a + w2a * ua), yb = cbv * (w0b * p2b + w1b * p1b + w2b * ubv);
            *(u32x4*)(cb + off) = pack8(ya, yb); p2a = p1a; p2b = p1b; p1a = ua; p1b = ubv; }
    }
    for (int it = gw; it < M * 8; it += NGW) {
        const int row = it >> 3, hh = it & 7; const size_t off = (size_t)row * RV + hh * 512 + lane * 8;
        f32x4 oa, ob, ga, gb; unpack8(*(const u32x4*)(vb + off), oa, ob); unpack8(*(const u32x4*)(sg + off), ga, gb);
        const float mu = wave_sum((oa.x + oa.y) + (oa.z + oa.w) + (ob.x + ob.y) + (ob.z + ob.w)) * (1.0f / 512.0f);
        oa = oa - mu; ob = ob - mu;
        const float var = wave_sum((oa.x * oa.x + oa.y * oa.y) + (oa.z * oa.z + oa.w * oa.w) + (ob.x * ob.x + ob.y * ob.y) + (ob.z * ob.z + ob.w * ob.w)) * (1.0f / 512.0f);
        const float rs = rsqrtf(var + EPS);
        const f32x4 wa = *(const f32x4*)(g_ret + hh * 512 + lane * 8), wb = *(const f32x4*)(g_ret + hh * 512 + lane * 8 + 4);
        *(u32x4*)(vb + off) = pack8(oa * rs * wa * ga, ob * rs * wb * gb);
    }
    {
        constexpr int I_CO = (D / 64) * (D / 32), I_RO = (RV / 64) * (D / 32), I_O = I_CO, I_FI = (D / 64) * (2 * DFF / 32), I_FO = (DFF / 64) * (D / 32), I_PG = I_CO, I_PP = (PLE / 64) * (D / 32);
        constexpr int NIT = I_CO + I_RO + I_O + I_FI + I_FO + I_PG + I_PP;
        for (int it = gw; it < NIT; it += NGW) {
            int r = it;
            if (r < I_CO) { transpose_matrix_item<0>(w_conv_out, D, D, WcoT, nullptr, r, scr, lane); continue; } r -= I_CO;
            if (r < I_RO) { transpose_matrix_item<0>(w_ret_out, RV, D, WroT, nullptr, r, scr, lane); continue; } r -= I_RO;
            if (r < I_O) { transpose_matrix_item<0>(w_o, D, D, WoT, nullptr, r, scr, lane); continue; } r -= I_O;
            if (r < I_FI) { transpose_matrix_item<2>(w_ffn_in, D, 2 * DFF, WfiT, g_ffn, r, scr, lane); continue; } r -= I_FI;
            if (r < I_FO) { transpose_matrix_item<0>(w_ffn_out, DFF, D, WfoT, nullptr, r, scr, lane); continue; } r -= I_FO;
            if (r < I_PG) { transpose_matrix_item<0>(w_ple_gate, D, D, WpgT, g_ple, r, scr, lane); continue; } r -= I_PG;
            transpose_matrix_item<0>(w_ple_proj, PLE, D, WppT, nullptr, r, scr, lane);
        }
    }
    grid.sync();

    if (PHMASK & 16) { pg8::Gemm g{cb, WcoT, M, D, D}; pg8::StaticOrder S; S.init(M, D, G, bx); EpiGate E{nullptr, sgc, sgc}; pg8::gemm_phase(lds, g, S, E); }
    if (PHMASK & 16) { pg8::Gemm g{vb, WroT, M, D, RV}; pg8::StaticOrder S; S.init(M, D, G, bx); EpiGate E{sgc, sgr, sgc}; pg8::gemm_phase(lds, g, S, E); }
    grid.sync();

    if (PHMASK & 32) { pg8::Gemm g{sgc, WoT, M, D, D}; pg8::StaticOrder S; S.init(M, D, G, bx); EpiRes E{x, x1, x1b, part1}; pg8::gemm_phase(lds, g, S, E); }
    grid.sync();

    if (PHMASK & 64) { pg8::Gemm g{x1b, WfiT, M, 2 * DFF, D}; pg8::StaticOrder S; S.init(M, 2 * DFF, G, bx); EpiFfnIn E{part1, hid}; pg8::gemm_phase(lds, g, S, E); }
    grid.sync();

    if (PHMASK & 128) { pg8::Gemm g{hid, WfoT, M, D, DFF}; pg8::StaticOrder S; S.init(M, D, G, bx); EpiRes E{x1, x1, x2b, part2}; pg8::gemm_phase(lds, g, S, E); }
    grid.sync();

    if (PHMASK & 256) { pg8::Gemm g{pb, WppT, M, D, PLE}; pg8::StaticOrder S; S.init(M, D, G, bx); EpiPlain E{ppb}; pg8::gemm_phase(lds, g, S, E); }
    if (PHMASK & 512) { pg8::Gemm g{x2b, WpgT, M, D, D}; pg8::StaticOrder S; S.init(M, D, G, bx); EpiPle E{part2, x1, ppb, a.out, part3}; pg8::gemm_phase(lds, g, S, E); }
    grid.sync();

    for (int m = gw; m < M; m += NGW) {
        float s = (lane < 32) ? part3[(size_t)m * 32 + lane] : 0.f;
        const float rs = rsqrtf(wave_sum(s) * (1.0f / D) + EPS);
        f32x4* xr = (f32x4*)(a.out + (size_t)m * D) + lane; const f32x4* gr = (const f32x4*)g_final + lane;
#pragma unroll
        for (int j = 0; j < 8; ++j) { const f32x4 v = xr[64 * j]; xr[64 * j] = v * rs * gr[64 * j]; }
    }
}

extern "C" void kernel_launch(void* const* d_in, const int* in_sizes, int n_in, void* d_out, int out_size, void* d_ws, size_t ws_size, hipStream_t stream) {
    static int grid = 0;
    if (grid == 0) {
        if (n_in != 16 || ws_size < WS_END || out_size != M * D) { fprintf(stderr, "kernel_launch: unexpected shapes (n_in %d, ws %zu, out %d); nothing launched\n", n_in, ws_size, out_size); grid = -1; return; }
        int dev = 0, cus = 0, per_cu = 0;
        (void)hipGetDevice(&dev);
        (void)hipDeviceGetAttribute(&cus, hipDeviceAttributeMultiprocessorCount, dev);
        (void)hipFuncSetAttribute((const void*)mega, hipFuncAttributeMaxDynamicSharedMemorySize, LDS_BYTES);
        (void)hipOccupancyMaxActiveBlocksPerMultiprocessor(&per_cu, (const void*)mega, 512, LDS_BYTES);
        if (per_cu < 1) per_cu = 1;
        grid = cus * per_cu;
        fprintf(stderr, "grid %d (cus %d per_cu %d) ws %zu\n", grid, cus, per_cu, ws_size);
    }
    if (grid < 0) return;
    Args a{};
    for (int i = 0; i < 16; ++i) a.in[i] = (const float*)d_in[i];
    a.out = (float*)d_out; a.ws = (unsigned char*)d_ws;
    void* args[] = {&a};
    hipError_t e = hipLaunchCooperativeKernel((const void*)mega, dim3(grid), dim3(512), args, LDS_BYTES, stream);
    if (e != hipSuccess) fprintf(stderr, "cooperative launch failed: %s (grid %d)\n", hipGetErrorString(e), grid);
}
```

```cpp
#include <hip/hip_runtime.h>
#include <hip/hip_cooperative_groups.h>
#include <cstdio>
#include <cstdint>
namespace cg = cooperative_groups;

#define LAS __attribute__((address_space(3)))
typedef unsigned short bf16_t;
typedef short bf16x8 __attribute__((ext_vector_type(8)));
typedef short s16x4 __attribute__((ext_vector_type(4)));
typedef float f32x4 __attribute__((ext_vector_type(4)));
typedef float f32x2_t __attribute__((ext_vector_type(2)));
typedef __bf16 bf16x2_t __attribute__((ext_vector_type(2)));
typedef unsigned u32x4 __attribute__((ext_vector_type(4)));
typedef unsigned u32x2 __attribute__((ext_vector_type(2)));

constexpr int M = 16384, D = 2048, SEQ = 4096, NIN = 22528, DFF = 5632, PLE = 256, RV = 4096;
constexpr float EPS = 1e-6f;
constexpr size_t MiB = 1u << 20;
constexpr size_t WS_PART1 = 0, WS_PART2 = 2 * MiB, WS_PART3 = 4 * MiB;
constexpr size_t WS_PB = 12 * MiB;
constexpr size_t WS_WINT = 20 * MiB;
constexpr size_t WS_H = 108 * MiB;
constexpr size_t WS_WCO = 20 * MiB, WS_WRO = 28 * MiB, WS_WO = 44 * MiB, WS_WFI = 52 * MiB, WS_WFO = 96 * MiB, WS_WPG = 118 * MiB, WS_WPP = 126 * MiB;
constexpr size_t WS_CB = 172 * MiB;
constexpr size_t WS_U = 236 * MiB;
constexpr size_t WS_Q = 300 * MiB, WS_K = 364 * MiB;
constexpr size_t WS_V = 428 * MiB;
constexpr size_t WS_SGR = 556 * MiB;
constexpr size_t WS_SGC = 620 * MiB;
constexpr size_t WS_END = 684 * MiB;

__device__ __forceinline__ unsigned cvtpk(float lo, float hi) { f32x2_t v = {lo, hi}; bf16x2_t b = __builtin_convertvector(v, bf16x2_t); return __builtin_bit_cast(unsigned, b); }
__device__ __forceinline__ float bflo(unsigned w) { return __uint_as_float(w << 16); }
__device__ __forceinline__ float bfhi(unsigned w) { return __uint_as_float(w & 0xffff0000u); }
__device__ __forceinline__ float sigmoidf_(float x) { return 1.0f / (1.0f + __expf(-x)); }
__device__ __forceinline__ float wave_sum(float v) {
#pragma unroll
    for (int o = 1; o < 64; o <<= 1) v += __shfl_xor(v, o);
    return v;
}

namespace pg8 {
constexpr int BM = 256, BK = 64, HALF = 128, HTB = HALF * BK * 2, STAGE_BYTES = 8 * HTB, NXCD = 8, WGM = 8;
__host__ __device__ __forceinline__ int lds_byte(int r, int c) { const int st = (r >> 4) * 2 + (c >> 5), rr = r & 15, cc = c & 31, ob = rr * 64 + cc * 2; return st * 1024 + (ob ^ (((ob >> 9) & 1) << 5)); }
__host__ __device__ __forceinline__ void stage_rc(int b, int& R, int& C) { const int st = b / 1024, sb = b % 1024, swz = sb ^ (((sb >> 9) & 1) << 5); R = (st >> 1) * 16 + swz / 64; C = (st & 1) * 32 + (swz % 64) / 2; }
__host__ __device__ __forceinline__ int perm32(int rho) { const int n = rho >> 4, i = rho & 15; return 8 * (i >> 2) + 4 * n + (i & 3); }

struct Unit { int pm, pn; };
struct Gemm { const bf16_t* A; const bf16_t* Bt; int M, N, K; };

struct StaticOrder {
    int nM, nN, nwg, G, c;
    __host__ __device__ void init(int M_, int N_, int G_, int c_) { nM = M_ / BM; nN = N_ / BM; nwg = nM * nN; G = G_; c = c_; }
    __host__ __device__ bool next(int i, Unit& u) const {
        const long L = (long)i * G + c; if (L >= nwg) return false;
        int wgid = (int)L; { const int q = nwg / NXCD, r = nwg % NXCD, xcd = wgid % NXCD, off = wgid / NXCD; wgid = (xcd < r ? xcd * (q + 1) : r * (q + 1) + (xcd - r) * q) + off; }
        const int nig = WGM * nN, gid = wgid / nig, fm = gid * WGM, gsz = (nM - fm) < WGM ? (nM - fm) : WGM;
        u.pm = fm + ((wgid % nig) % gsz); u.pn = (wgid % nig) / gsz; return true;
    }
};

template <class Epi, class Sched>
__device__ __forceinline__ void gemm_phase(LAS unsigned char* lds, const Gemm g, const Sched& S, const Epi& E) {
    int tid_ = threadIdx.x; asm volatile("" : "+v"(tid_));
    const int tid = tid_, wid = __builtin_amdgcn_readfirstlane(tid >> 6), lane = tid & 63, wr = wid >> 2, wc = wid & 3, fr = lane & 15, fq = lane >> 4;
    int K_ = g.K; asm volatile("" : "+s"(K_));
    const int K = K_, nt = K / BK;
    unsigned voffA[2], voffB[2];
#pragma unroll
    for (int i = 0; i < 2; ++i) { int R, C; stage_rc(tid * 16 + i * 8192, R, C); const int Rb = (R & ~31) + perm32(R & 31);
        voffA[i] = (unsigned)(R * K + C) * 2u; voffB[i] = (unsigned)(Rb * K + C) * 2u; }
    const size_t kstep = (size_t)(BK * 2);
    const size_t hstep = (size_t)HALF * K * 2;
    const size_t tstep = 2 * hstep;
    const unsigned ldsw = (unsigned)wid * 1024u;
    const int aoff = lds_byte(wr * 64 + fr, fq * 8), boff = lds_byte(wc * 32 + fr, fq * 8);
#define PG8_SA(b, h) (((b) * 2 + (h)) * HTB)
#define PG8_SB(b, h) ((4 + (b) * 2 + (h)) * HTB)
#define PG8_STAGE(bufoff, gbase, voff) do { _Pragma("unroll") for (int _i = 0; _i < 2; ++_i) \
        __builtin_amdgcn_global_load_lds((const unsigned*)((const char*)(gbase) + (voff)[_i]), (LAS unsigned*)(lds + (bufoff) + ldsw + _i * 8192), 16, 0, 0); } while (0)
#define PG8_LDA(dst, b, h) do { _Pragma("unroll") for (int m = 0; m < 4; ++m) _Pragma("unroll") for (int k = 0; k < 2; ++k) dst[m][k] = *(const LAS bf16x8*)(lds + PG8_SA(b, h) + aoff + m * 2048 + k * 1024); } while (0)
#define PG8_LDB(dst, b, h) do { _Pragma("unroll") for (int n = 0; n < 2; ++n) _Pragma("unroll") for (int k = 0; k < 2; ++k) dst[n][k] = *(const LAS bf16x8*)(lds + PG8_SB(b, h) + boff + n * 2048 + k * 1024); } while (0)
#define PG8_MMA(ai, bj, At, Bt) do { __builtin_amdgcn_s_setprio(1); _Pragma("unroll") for (int m = 0; m < 4; ++m) _Pragma("unroll") for (int n = 0; n < 2; ++n) _Pragma("unroll") for (int k = 0; k < 2; ++k) \
        acc[ai][bj][m][n] = __builtin_amdgcn_mfma_f32_16x16x32_bf16(Bt[n][k], At[m][k], acc[ai][bj][m][n], 0, 0, 0); __builtin_amdgcn_s_setprio(0); } while (0)
#define PG8_WAIT_V(n) asm volatile("s_waitcnt vmcnt(" #n ")" ::: "memory")
#define PG8_WAIT_L(n) asm volatile("s_waitcnt lgkmcnt(" #n ")" ::: "memory")
#define PG8_BAR __builtin_amdgcn_s_barrier()
#define PG8_SCHED __builtin_amdgcn_sched_barrier(0)
    Unit cur, nxt; int ui = 0;
    if (!S.next(0, cur)) return;
    f32x4 acc[2][2][4][2];
#pragma unroll
    for (int a = 0; a < 2; ++a)
#pragma unroll
        for (int b = 0; b < 2; ++b)
#pragma unroll
            for (int m = 0; m < 4; ++m)
#pragma unroll
                for (int n = 0; n < 2; ++n) acc[a][b][m][n] = (f32x4){0.f, 0.f, 0.f, 0.f};
    bf16x8 At[4][2], B0[2][2], B1[2][2];
    const char* cA = (const char*)g.A + (size_t)cur.pm * tstep; const char* cB = (const char*)g.Bt + (size_t)cur.pn * tstep;
    PG8_STAGE(PG8_SB(0, 0), cB, voffB); PG8_STAGE(PG8_SB(0, 1), cB + hstep, voffB); PG8_STAGE(PG8_SA(0, 0), cA, voffA); PG8_STAGE(PG8_SA(0, 1), cA + hstep, voffA);
    if (wr == 1) PG8_BAR;
    PG8_WAIT_V(2); PG8_BAR;
    PG8_STAGE(PG8_SB(1, 0), cB + kstep, voffB); PG8_STAGE(PG8_SA(1, 0), cA + kstep, voffA); PG8_STAGE(PG8_SB(1, 1), cB + hstep + kstep, voffB);
    PG8_WAIT_V(6); PG8_BAR;
    for (;;) {
        const bool has_next = S.next(ui + 1, nxt);
        const char* nA = has_next ? (const char*)g.A + (size_t)nxt.pm * tstep : cA; const char* nB = has_next ? (const char*)g.Bt + (size_t)nxt.pn * tstep : cB;
        for (int t = 0; t < nt; t += 2) {
            const bool last = (t == nt - 2);
            const char* a1 = cA + (size_t)(t + 1) * kstep;
            const char* a2 = last ? nA : cA + (size_t)(t + 2) * kstep; const char* b2 = last ? nB : cB + (size_t)(t + 2) * kstep;
            const char* a3 = a2 + kstep; const char* b3 = b2 + kstep;
            PG8_LDB(B0, 0, 0); PG8_LDB(B1, 0, 1); PG8_SCHED; PG8_LDA(At, 0, 0); PG8_STAGE(PG8_SA(1, 1), a1 + hstep, voffA);
            PG8_WAIT_V(8); PG8_WAIT_L(0); PG8_BAR; PG8_MMA(0, 0, At, B0); PG8_MMA(0, 1, At, B1); PG8_BAR; PG8_SCHED;
            PG8_LDA(At, 0, 1); PG8_STAGE(PG8_SB(0, 0), b2, voffB); PG8_STAGE(PG8_SB(0, 1), b2 + hstep, voffB); PG8_STAGE(PG8_SA(0, 0), a2, voffA);
            PG8_WAIT_V(8); PG8_WAIT_L(0); PG8_BAR; PG8_MMA(1, 0, At, B0); PG8_MMA(1, 1, At, B1); PG8_BAR; PG8_SCHED;
            PG8_LDB(B0, 1, 0); PG8_LDB(B1, 1, 1); PG8_SCHED; PG8_LDA(At, 1, 0); PG8_STAGE(PG8_SA(0, 1), a2 + hstep, voffA);
            PG8_WAIT_V(8); PG8_WAIT_L(0); PG8_BAR; PG8_MMA(0, 0, At, B0); PG8_MMA(0, 1, At, B1); PG8_BAR; PG8_SCHED;
            PG8_LDA(At, 1, 1); PG8_STAGE(PG8_SB(1, 0), b3, voffB); PG8_STAGE(PG8_SB(1, 1), b3 + hstep, voffB); PG8_STAGE(PG8_SA(1, 0), a3, voffA);
            PG8_WAIT_V(8); PG8_WAIT_L(0); PG8_BAR; PG8_MMA(1, 0, At, B0); PG8_MMA(1, 1, At, B1); PG8_BAR; PG8_SCHED;
        }
        if (wr == 0) PG8_BAR;
        E(acc, cur, wr, wc, fr, fq);
        if (!has_next) break;
#pragma unroll
        for (int a = 0; a < 2; ++a)
#pragma unroll
            for (int b = 0; b < 2; ++b)
#pragma unroll
                for (int m = 0; m < 4; ++m)
#pragma unroll
                    for (int n = 0; n < 2; ++n) acc[a][b][m][n] = (f32x4){0.f, 0.f, 0.f, 0.f};
        cur = nxt; cA = nA; cB = nB; ++ui;
        if (wr == 1) PG8_BAR;
    }
    PG8_WAIT_V(0);
    PG8_BAR;
#undef PG8_SA
#undef PG8_SB
#undef PG8_STAGE
#undef PG8_LDA
#undef PG8_LDB
#undef PG8_MMA
#undef PG8_WAIT_V
#undef PG8_WAIT_L
#undef PG8_BAR
#undef PG8_SCHED
}
}

typedef f32x4 Acc[2][2][4][2];

__device__ __forceinline__ float row_rstd(const float* part, int row, int fq) {
    const f32x4* p = (const f32x4*)(part + (size_t)row * 32 + fq * 8);
    const f32x4 a = p[0], b = p[1];
    float s = ((a.x + a.y) + (a.z + a.w)) + ((b.x + b.y) + (b.z + b.w));
    s += __shfl_xor(s, 16); s += __shfl_xor(s, 32);
    return rsqrtf(s * (1.0f / D) + EPS);
}
__device__ __forceinline__ u32x4 pack8(const f32x4 a, const f32x4 b) { u32x4 w; w.x = cvtpk(a[0], a[1]); w.y = cvtpk(a[2], a[3]); w.z = cvtpk(b[0], b[1]); w.w = cvtpk(b[2], b[3]); return w; }
__device__ __forceinline__ void unpack8(const u32x4 w, f32x4& a, f32x4& b) { a = (f32x4){bflo(w.x), bfhi(w.x), bflo(w.y), bfhi(w.y)}; b = (f32x4){bflo(w.z), bfhi(w.z), bflo(w.w), bfhi(w.w)}; }

struct EpiInProj {
    bf16_t *cb, *u, *q, *k, *v, *sg, *sgc, *sgr;
    __device__ __forceinline__ void operator()(const Acc& acc, const pg8::Unit& un, int wr, int wc, int fr, int fq) const {
        const int pn = un.pn, row0 = un.pm * 256 + wr * 64 + fr, lc = wc * 32 + 8 * fq;
        if (pn >= 8 && pn < 24) {
            bf16_t* base = u + (size_t)(pn - 8) * 128 + lc;
#pragma unroll
            for (int ai = 0; ai < 2; ++ai)
#pragma unroll
                for (int m = 0; m < 4; ++m) { const f32x4 a = acc[ai][0][m][0] * acc[ai][1][m][0], b = acc[ai][0][m][1] * acc[ai][1][m][1];
                    *(u32x4*)(base + (size_t)(row0 + ai * 128 + m * 16) * D) = pack8(a, b); }
        } else if (pn >= 24 && pn < 40) {
            const bool isk = pn >= 32; const int head = (pn - 24) & 7; const float sc = isk ? 0.0625f : 1.0f;
            bf16_t* base = (isk ? k : q) + head * 256 + lc;
            float cj[8];
#pragma unroll
            for (int e = 0; e < 8; ++e) cj[e] = exp2f(-(float)(lc + e) * (13.287712379549449f / 128.0f)) * 0.15915494309189535f;
#pragma unroll
            for (int ai = 0; ai < 2; ++ai)
#pragma unroll
                for (int m = 0; m < 4; ++m) {
                    const int row = row0 + ai * 128 + m * 16; const float pos = (float)(row & (SEQ - 1));
                    f32x4 o1[2], o2[2];
#pragma unroll
                    for (int n = 0; n < 2; ++n)
#pragma unroll
                        for (int e = 0; e < 4; ++e) {
                            float r = pos * cj[n * 4 + e]; r = r - floorf(r);
                            const float sn = __builtin_amdgcn_sinf(r), cs = __builtin_amdgcn_cosf(r);
                            const float t1 = acc[ai][0][m][n][e], t2 = acc[ai][1][m][n][e];
                            o1[n][e] = (t1 * cs - t2 * sn) * sc; o2[n][e] = (t2 * cs + t1 * sn) * sc;
                        }
                    bf16_t* rp = base + (size_t)row * D;
                    *(u32x4*)rp = pack8(o1[0], o1[1]); *(u32x4*)(rp + 128) = pack8(o2[0], o2[1]);
                }
        } else {
            bf16_t* base; int ld, act;
            if (pn < 8) { base = cb + pn * 256; ld = D; act = 0; }
            else if (pn < 56) { base = v + (pn - 40) * 256; ld = RV; act = 0; }
            else if (pn < 72) { base = sg + (pn - 56) * 256; ld = RV; act = 1; }
            else if (pn < 80) { base = sgc + (pn - 72) * 256; ld = D; act = 2; }
            else { base = sgr + (pn - 80) * 256; ld = D; act = 2; }
            base += lc;
#pragma unroll
            for (int ai = 0; ai < 2; ++ai)
#pragma unroll
                for (int m = 0; m < 4; ++m) { bf16_t* rp = base + (size_t)(row0 + ai * 128 + m * 16) * ld;
#pragma unroll
                    for (int bj = 0; bj < 2; ++bj) { f32x4 a = acc[ai][bj][m][0], b = acc[ai][bj][m][1];
                        if (act) {
#pragma unroll
                            for (int e = 0; e < 4; ++e) { const float sa = sigmoidf_(a[e]), sb = sigmoidf_(b[e]); a[e] = act == 1 ? a[e] * sa : sa; b[e] = act == 1 ? b[e] * sb : sb; } }
                        *(u32x4*)(rp + bj * 128) = pack8(a, b); } }
        }
    }
};

struct EpiGate {
    const bf16_t* T; const bf16_t* G; bf16_t* O;
    __device__ __forceinline__ void operator()(const Acc& acc, const pg8::Unit& un, int wr, int wc, int fr, int fq) const {
        const int row0 = un.pm * 256 + wr * 64 + fr; const size_t col0 = (size_t)un.pn * 256 + wc * 32 + 8 * fq;
#pragma unroll
        for (int ai = 0; ai < 2; ++ai)
#pragma unroll
            for (int m = 0; m < 4; ++m) { const size_t off = (size_t)(row0 + ai * 128 + m * 16) * D + col0;
#pragma unroll
                for (int bj = 0; bj < 2; ++bj) { f32x4 ga, gb; unpack8(*(const u32x4*)(G + off + bj * 128), ga, gb);
                    f32x4 a = ga * acc[ai][bj][m][0], b = gb * acc[ai][bj][m][1];
                    if (T) { f32x4 ta, tb; unpack8(*(const u32x4*)(T + off + bj * 128), ta, tb); a += ta; b += tb; }
                    *(u32x4*)(O + off + bj * 128) = pack8(a, b); } }
    }
};

struct EpiRes {
    const float* xin; float* xout; bf16_t* xb; float* part;
    __device__ __forceinline__ void operator()(const Acc& acc, const pg8::Unit& un, int wr, int wc, int fr, int fq) const {
        const int row0 = un.pm * 256 + wr * 64 + fr; const size_t col0 = (size_t)un.pn * 256 + wc * 32 + 8 * fq;
#pragma unroll
        for (int ai = 0; ai < 2; ++ai)
#pragma unroll
            for (int m = 0; m < 4; ++m) { const int row = row0 + ai * 128 + m * 16; const size_t off = (size_t)row * D + col0; float ss = 0.f;
#pragma unroll
                for (int bj = 0; bj < 2; ++bj) {
                    const f32x4 a = *(const f32x4*)(xin + off + bj * 128) + acc[ai][bj][m][0], b = *(const f32x4*)(xin + off + bj * 128 + 4) + acc[ai][bj][m][1];
                    *(f32x4*)(xout + off + bj * 128) = a; *(f32x4*)(xout + off + bj * 128 + 4) = b;
                    *(u32x4*)(xb + off + bj * 128) = pack8(a, b);
                    ss += ((a[0] * a[0] + a[1] * a[1]) + (a[2] * a[2] + a[3] * a[3])) + ((b[0] * b[0] + b[1] * b[1]) + (b[2] * b[2] + b[3] * b[3])); }
                ss += __shfl_xor(ss, 16); ss += __shfl_xor(ss, 32);
                if (fq == 0) part[(size_t)row * 32 + un.pn * 4 + wc] = ss; }
    }
};

struct EpiFfnIn {
    const float* part; bf16_t* hid;
    __device__ __forceinline__ void operator()(const Acc& acc, const pg8::Unit& un, int wr, int wc, int fr, int fq) const {
        const int row0 = un.pm * 256 + wr * 64 + fr; const size_t col0 = (size_t)un.pn * 128 + wc * 32 + 8 * fq;
#pragma unroll
        for (int ai = 0; ai < 2; ++ai)
#pragma unroll
            for (int m = 0; m < 4; ++m) { const int row = row0 + ai * 128 + m * 16; const float rs = row_rstd(part, row, fq);
                f32x4 o[2];
#pragma unroll
                for (int n = 0; n < 2; ++n)
#pragma unroll
                    for (int e = 0; e < 4; ++e) { const float a = rs * acc[ai][0][m][n][e], b = rs * acc[ai][1][m][n][e]; o[n][e] = a * sigmoidf_(a) * b; }
                *(u32x4*)(hid + (size_t)row * DFF + col0) = pack8(o[0], o[1]); }
    }
};

struct EpiPlain {
    bf16_t* O;
    __device__ __forceinline__ void operator()(const Acc& acc, const pg8::Unit& un, int wr, int wc, int fr, int fq) const {
        const int row0 = un.pm * 256 + wr * 64 + fr; const size_t col0 = (size_t)un.pn * 256 + wc * 32 + 8 * fq;
#pragma unroll
        for (int ai = 0; ai < 2; ++ai)
#pragma unroll
            for (int m = 0; m < 4; ++m) { const size_t off = (size_t)(row0 + ai * 128 + m * 16) * D + col0;
#pragma unroll
                for (int bj = 0; bj < 2; ++bj) *(u32x4*)(O + off + bj * 128) = pack8(acc[ai][bj][m][0], acc[ai][bj][m][1]); }
    }
};

struct EpiPle {
    const float* part_in; const float* xin; const bf16_t* pp; float* xout; float* part;
    __device__ __forceinline__ void operator()(const Acc& acc, const pg8::Unit& un, int wr, int wc, int fr, int fq) const {
        const int row0 = un.pm * 256 + wr * 64 + fr; const size_t col0 = (size_t)un.pn * 256 + wc * 32 + 8 * fq;
#pragma unroll
        for (int ai = 0; ai < 2; ++ai)
#pragma unroll
            for (int m = 0; m < 4; ++m) { const int row = row0 + ai * 128 + m * 16; const size_t off = (size_t)row * D + col0; float ss = 0.f;
                const float rs = row_rstd(part_in, row, fq);
#pragma unroll
                for (int bj = 0; bj < 2; ++bj) { f32x4 pa, pb; unpack8(*(const u32x4*)(pp + off + bj * 128), pa, pb);
                    f32x4 a = *(const f32x4*)(xin + off + bj * 128), b = *(const f32x4*)(xin + off + bj * 128 + 4);
#pragma unroll
                    for (int e = 0; e < 4; ++e) { a[e] += sigmoidf_(rs * acc[ai][bj][m][0][e]) * pa[e]; b[e] += sigmoidf_(rs * acc[ai][bj][m][1][e]) * pb[e]; }
                    *(f32x4*)(xout + off + bj * 128) = a; *(f32x4*)(xout + off + bj * 128 + 4) = b;
                    ss += ((a[0] * a[0] + a[1] * a[1]) + (a[2] * a[2] + a[3] * a[3])) + ((b[0] * b[0] + b[1] * b[1]) + (b[2] * b[2] + b[3] * b[3])); }
                ss += __shfl_xor(ss, 16); ss += __shfl_xor(ss, 32);
                if (fq == 0) part[(size_t)row * 32 + un.pn * 4 + wc] = ss; }
    }
};

__device__ __forceinline__ void transpose_item(const float* W, int K, int N, bf16_t* WT, int drow0, int k0, int n0, const float* gk, LAS float* scr, int lane) {
#pragma unroll 8
    for (int i = 0; i < 32; ++i) { const int kk = 2 * i + (lane >> 5); float w = W[(size_t)(k0 + kk) * N + n0 + (lane & 31)]; if (gk) w *= gk[k0 + kk]; scr[kk * 33 + (lane & 31)] = w; }
    asm volatile("s_waitcnt lgkmcnt(0)" ::: "memory");
    const int c = lane & 7;
#pragma unroll
    for (int j = 0; j < 4; ++j) { const int n = (lane >> 3) + 8 * j; const LAS float* s = scr + (8 * c) * 33 + n;
        u32x4 o; o.x = cvtpk(s[0 * 33], s[1 * 33]); o.y = cvtpk(s[2 * 33], s[3 * 33]); o.z = cvtpk(s[4 * 33], s[5 * 33]); o.w = cvtpk(s[6 * 33], s[7 * 33]);
        *(u32x4*)(WT + (size_t)(drow0 + n) * K + k0 + 8 * c) = o; }
    asm volatile("s_waitcnt lgkmcnt(0)" ::: "memory");
}
template <int MODE>
__device__ __forceinline__ void transpose_matrix_item(const float* W, int K, int N, bf16_t* WT, const float* gk, int item, LAS float* scr, int lane) {
    const int nblk = N / 32, kb = item / nblk, nb = item % nblk, n0 = nb * 32; int drow0 = n0;
    if (MODE == 1) { if (n0 >= 2048 && n0 < 4096) { const int c = n0 - 2048; drow0 = 2048 + (c >> 7) * 256 + (c & 127); } else if (n0 >= 4096 && n0 < 6144) { const int c = n0 - 4096; drow0 = 2048 + (c >> 7) * 256 + 128 + (c & 127); } }
    if (MODE == 2) { if (n0 < DFF) drow0 = (n0 >> 7) * 256 + (n0 & 127); else { const int c = n0 - DFF; drow0 = (c >> 7) * 256 + 128 + (c & 127); } }
    transpose_item(W, K, N, WT, drow0, kb * 64, n0, gk, scr, lane);
}

typedef short v4i16_t __attribute__((ext_vector_type(4)));
__device__ __forceinline__ bf16x8 tr_read8(const LAS unsigned char* p, int rowstride4  ) {
    const v4i16_t a = __builtin_amdgcn_ds_read_tr16_b64_v4i16((LAS v4i16_t*)p);
    const v4i16_t b = __builtin_amdgcn_ds_read_tr16_b64_v4i16((LAS v4i16_t*)(p + rowstride4));
    return __builtin_shufflevector(a, b, 0, 1, 2, 3, 4, 5, 6, 7);
}

__device__ __forceinline__ void retention_item(LAS unsigned char* lds, const bf16_t* Qg, const bf16_t* Kg, bf16_t* Vg, int item) {
    constexpr int QP = 264, VP = 72;
    constexpr int QS = 0, KS = 33792, ST = 67584, VS = 101376, VZ = 110592, SS = 119808;
    int tid_ = threadIdx.x; asm volatile("" : "+v"(tid_));
    const int tid = tid_, lane = tid & 63, w = __builtin_amdgcn_readfirstlane(tid >> 6);
    const int b = item >> 6, h = (item >> 3) & 7, es = item & 7;
    const int l15 = lane & 15, g = lane >> 4, tq = (lane >> 2) & 3, tp = lane & 3;
    const float xg = exp2f(-5.0f - (float)h);
    const float lng = -xg * (1.0f + xg * (0.5f + xg * (1.0f / 3.0f + xg * (0.25f + xg * (0.2f + xg * (1.0f / 6.0f))))));
    const float l2g = lng * 1.4426950408889634f;
    const float gchunk = exp2f(l2g * 64.0f);
    for (int i = tid; i < 33792 / 16; i += 512) *(LAS u32x4*)(lds + ST + i * 16) = (u32x4){0u, 0u, 0u, 0u};
    f32x4 accT[2][4];
#pragma unroll
    for (int a = 0; a < 2; ++a)
#pragma unroll
        for (int e = 0; e < 4; ++e) accT[a][e] = (f32x4){0.f, 0.f, 0.f, 0.f};
    const int vrow = tid >> 3, vch = tid & 7;
    const float zeta = exp2f(l2g * (float)(63 - vrow));
    const size_t rowbase0 = (size_t)b * SEQ;
    u32x4 qreg[4], kreg[4], vreg;
#define RET_LOAD(i_) do { const size_t rb_ = rowbase0 + (size_t)(i_) * 64; \
        _Pragma("unroll") for (int j = 0; j < 4; ++j) { const int idx = tid + 512 * j, row = idx >> 5, ch = idx & 31; \
            qreg[j] = *(const u32x4*)(Qg + (rb_ + row) * D + h * 256 + ch * 8); kreg[j] = *(const u32x4*)(Kg + (rb_ + row) * D + h * 256 + ch * 8); } \
        vreg = *(const u32x4*)(Vg + (rb_ + vrow) * RV + h * 512 + es * 64 + vch * 8); } while (0)
    RET_LOAD(0);
    const int tr = w >> 1, tc0 = 2 * (w & 1);
    for (int i = 0; i < 64; ++i) {
#pragma unroll
        for (int j = 0; j < 4; ++j) { const int idx = tid + 512 * j, row = idx >> 5, ch = idx & 31;
            *(LAS u32x4*)(lds + QS + (row * QP + ch * 8) * 2) = qreg[j]; *(LAS u32x4*)(lds + KS + (row * QP + ch * 8) * 2) = kreg[j]; }
        { *(LAS u32x4*)(lds + VS + (vrow * VP + vch * 8) * 2) = vreg;
          f32x4 a, bb; unpack8(vreg, a, bb); a = a * zeta; bb = bb * zeta; *(LAS u32x4*)(lds + VZ + (vrow * VP + vch * 8) * 2) = pack8(a, bb); }
        if (i < 63) RET_LOAD(i + 1);
        __syncthreads();
        f32x4 accS[2], accC[2];
#pragma unroll
        for (int t = 0; t < 2; ++t) { accS[t] = (f32x4){0.f, 0.f, 0.f, 0.f}; accC[t] = (f32x4){0.f, 0.f, 0.f, 0.f}; }
#pragma unroll
        for (int kk = 0; kk < 8; ++kk) {
            const int dof = (kk * 32 + 8 * g) * 2;
            const bf16x8 qf = *(const LAS bf16x8*)(lds + QS + (tr * 16 + l15) * (QP * 2) + dof);
#pragma unroll
            for (int t = 0; t < 2; ++t) {
                const bf16x8 kf = *(const LAS bf16x8*)(lds + KS + ((tc0 + t) * 16 + l15) * (QP * 2) + dof);
                accS[t] = __builtin_amdgcn_mfma_f32_16x16x32_bf16(kf, qf, accS[t], 0, 0, 0);
                const bf16x8 sf = *(const LAS bf16x8*)(lds + ST + ((tc0 + t) * 16 + l15) * (QP * 2) + dof);
                accC[t] = __builtin_amdgcn_mfma_f32_16x16x32_bf16(sf, qf, accC[t], 0, 0, 0);
            }
        }
        const int crow = tr * 16 + l15;
#pragma unroll
        for (int t = 0; t < 2; ++t) { const int m0 = (tc0 + t) * 16 + 4 * g; f32x4 sv;
#pragma unroll
            for (int e = 0; e < 4; ++e) { const int dd = crow - (m0 + e); sv[e] = accS[t][e] * exp2f(l2g * (float)(dd < 0 ? -dd : dd)); }
            u32x2 pk; pk.x = cvtpk(sv[0], sv[1]); pk.y = cvtpk(sv[2], sv[3]);
            *(LAS u32x2*)(lds + SS + (crow * VP + m0) * 2) = pk; }
        __syncthreads();
        f32x4 accI[2];
#pragma unroll
        for (int t = 0; t < 2; ++t) accI[t] = (f32x4){0.f, 0.f, 0.f, 0.f};
#pragma unroll
        for (int ks = 0; ks < 2; ++ks) {
            const bf16x8 sfr = *(const LAS bf16x8*)(lds + SS + (crow * VP + ks * 32 + 8 * g) * 2);
#pragma unroll
            for (int t = 0; t < 2; ++t) {
                const bf16x8 vf = tr_read8(lds + VS + ((ks * 32 + 8 * g + tq) * VP + (tc0 + t) * 16 + 4 * tp) * 2, 4 * VP * 2);
                accI[t] = __builtin_amdgcn_mfma_f32_16x16x32_bf16(vf, sfr, accI[t], 0, 0, 0);
            }
        }
        { const float xi = exp2f(l2g * (float)(crow + 1)); const size_t rb = rowbase0 + (size_t)i * 64;
#pragma unroll
          for (int t = 0; t < 2; ++t) { const f32x4 o = accI[t] + accC[t] * xi; u32x2 pk; pk.x = cvtpk(o[0], o[1]); pk.y = cvtpk(o[2], o[3]);
              *(u32x2*)(Vg + (rb + crow) * RV + h * 512 + es * 64 + (tc0 + t) * 16 + 4 * g) = pk; } }
#pragma unroll
        for (int a = 0; a < 2; ++a)
#pragma unroll
            for (int e = 0; e < 4; ++e) accT[a][e] = accT[a][e] * gchunk;
#pragma unroll
        for (int ks = 0; ks < 2; ++ks) {
            bf16x8 kfr[2], vzf[4];
#pragma unroll
            for (int a = 0; a < 2; ++a) kfr[a] = tr_read8(lds + KS + ((ks * 32 + 8 * g + tq) * QP + (2 * w + a) * 16 + 4 * tp) * 2, 4 * QP * 2);
#pragma unroll
            for (int e = 0; e < 4; ++e) vzf[e] = tr_read8(lds + VZ + ((ks * 32 + 8 * g + tq) * VP + e * 16 + 4 * tp) * 2, 4 * VP * 2);
#pragma unroll
            for (int a = 0; a < 2; ++a)
#pragma unroll
                for (int e = 0; e < 4; ++e) accT[a][e] = __builtin_amdgcn_mfma_f32_16x16x32_bf16(kfr[a], vzf[e], accT[a][e], 0, 0, 0);
        }
#pragma unroll
        for (int a = 0; a < 2; ++a)
#pragma unroll
            for (int e = 0; e < 4; ++e) { u32x2 pk; pk.x = cvtpk(accT[a][e][0], accT[a][e][1]); pk.y = cvtpk(accT[a][e][2], accT[a][e][3]);
                *(LAS u32x2*)(lds + ST + ((e * 16 + l15) * QP + (2 * w + a) * 16 + 4 * g) * 2) = pk; }
        __syncthreads();
    }
#undef RET_LOAD
}

#define XB_TMO      128
#define XB_XCNT(j)  (256  + 64 * (j))
#define XB_XSUB(j)  (1280 + 64 * (j))
#define XB_XGEN(j)  (2304 + 64 * (j))
#define XB_TOP      3328
#define XB_TOPGEN   3392
#define XCD_BAR_WORDS 3456
#define XB_SPIN_CAP (1u << 18)
__device__ __forceinline__ unsigned xb_ld(unsigned* p)              { return __hip_atomic_load(p, __ATOMIC_RELAXED, __HIP_MEMORY_SCOPE_AGENT); }
__device__ __forceinline__ unsigned xb_add(unsigned* p, unsigned v) { return __hip_atomic_fetch_add(p, v, __ATOMIC_RELAXED, __HIP_MEMORY_SCOPE_AGENT); }
__device__ __forceinline__ unsigned xb_xcc_id() { return (unsigned)__builtin_amdgcn_s_getreg((3 << 11) | 20) & 0xFu; }
#define XB_SPIN(cond, bar) do { unsigned _sp = 0; while (cond) { __builtin_amdgcn_s_sleep(1); \
    if ((++_sp & 255u) == 0u) { if (xb_ld(&(bar)[XB_TMO])) break; if (_sp > XB_SPIN_CAP) { atomicAdd(&(bar)[XB_TMO], 1u); break; } } } } while (0)
struct XcdBarrier { unsigned* bar; unsigned x; volatile LAS unsigned* st; };
__device__ __forceinline__ XcdBarrier xcd_barrier_post(unsigned* bar, volatile LAS unsigned* st) {
    XcdBarrier b; b.bar = bar; b.x = xb_xcc_id(); b.st = st;
    if (threadIdx.x == 0) (void)xb_add(&bar[XB_XCNT(b.x)], 1u);
    return b;
}
__device__ __forceinline__ void xcd_barrier_complete(unsigned* bar, unsigned x, unsigned& nloc, unsigned& nx) {
    const unsigned G = gridDim.x * gridDim.y * gridDim.z;
    unsigned sum, cnt, mine, sp = 0u;
    for (;;) {
        sum = 0u; cnt = 0u; mine = 0u;
#pragma unroll
        for (unsigned j = 0; j < 16; ++j) { const unsigned c = xb_ld(&bar[XB_XCNT(j)]); sum += c; cnt += (c > 0u) ? 1u : 0u; mine = (j == x) ? c : mine; }
        if (sum == G) break;
        __builtin_amdgcn_s_sleep(1);
        if ((++sp & 255u) == 0u) { if (xb_ld(&bar[XB_TMO])) break; if (sp > XB_SPIN_CAP) { atomicAdd(&bar[XB_TMO], 1u); break; } }
    }
    nloc = mine > 0u ? mine : 1u; nx = cnt > 0u ? cnt : 1u;
}
__device__ __forceinline__ void xcd_barrier(const XcdBarrier& b) {
    asm volatile("s_waitcnt vmcnt(0)" ::: "memory");
    __syncthreads();
    if (threadIdx.x == 0) {
        unsigned* bar = b.bar;
        __builtin_amdgcn_s_waitcnt(0);
        unsigned nloc = b.st[0], nx = b.st[1];
        if (nloc == 0u) { xcd_barrier_complete(bar, b.x, nloc, nx); b.st[0] = nloc; b.st[1] = nx; }
        const unsigned old = xb_add(&bar[XB_XSUB(b.x)], 1u);
        const unsigned gen = old / nloc;
        if (old + 1u == (gen + 1u) * nloc) {
            __builtin_amdgcn_fence(__ATOMIC_RELEASE, "agent");
            asm volatile("s_waitcnt vmcnt(0)" ::: "memory");
            const unsigned og = xb_add(&bar[XB_TOP], 1u);
            const unsigned tg = og / nx;
            if (og + 1u == (tg + 1u) * nx) xb_add(&bar[XB_TOPGEN], 1u);
            else XB_SPIN(xb_ld(&bar[XB_TOPGEN]) == tg, bar);
            __builtin_amdgcn_fence(__ATOMIC_ACQUIRE, "agent");
            xb_add(&bar[XB_XGEN(b.x)], 1u);
            asm volatile("s_waitcnt vmcnt(0)" ::: "memory");
        } else {
            XB_SPIN(xb_ld(&bar[XB_XGEN(b.x)]) == gen, bar);
            __builtin_amdgcn_fence(__ATOMIC_ACQUIRE, "agent");
            asm volatile("s_waitcnt vmcnt(0)" ::: "memory");
        }
    }
    __syncthreads();
}

struct Args { const float* in[16]; float* out; unsigned char* ws; };
constexpr int LDS_BYTES = 147456;
#ifndef PROBE_LO
#define PROBE_LO -1
#define PROBE_HI -1
#define PROBE_MULT 1
#endif
#if PROBE_LO >= 0
#define STAMP(k) do { if (blockIdx.x == 0 && threadIdx.x == 0) ((unsigned long long*)(a.ws + 8 * MiB))[k] = __builtin_amdgcn_s_memrealtime(); } while (0)
#else
#define STAMP(k) do { } while (0)
#endif

__global__ void __launch_bounds__(512, 2) mega(Args a) {
    extern __shared__ __attribute__((aligned(16))) unsigned char lds_raw[];
    LAS unsigned char* lds = (LAS unsigned char*)lds_raw;
    cg::grid_group grid = cg::this_grid();
    const int tid = threadIdx.x, lane = tid & 63, wave = __builtin_amdgcn_readfirstlane(tid >> 6);
    const int G = gridDim.x, bx = blockIdx.x;
    const int gw = bx * 8 + wave, NGW = G * 8;
    unsigned char* ws = a.ws;
    const float* x = a.in[0]; const float* p = a.in[1]; const float* g_mix = a.in[2]; const float* w_in = a.in[3]; const float* conv_w = a.in[4];
    const float* w_conv_out = a.in[5]; const float* g_ret = a.in[6]; const float* w_ret_out = a.in[7]; const float* w_o = a.in[8]; const float* g_ffn = a.in[9];
    const float* w_ffn_in = a.in[10]; const float* w_ffn_out = a.in[11]; const float* g_ple = a.in[12]; const float* w_ple_gate = a.in[13]; const float* w_ple_proj = a.in[14];
    const float* g_final = a.in[15];
    float* part1 = (float*)(ws + WS_PART1); float* part2 = (float*)(ws + WS_PART2); float* part3 = (float*)(ws + WS_PART3);
    bf16_t* pb = (bf16_t*)(ws + WS_PB); bf16_t* WinT = (bf16_t*)(ws + WS_WINT); bf16_t* hb = (bf16_t*)(ws + WS_H);
    bf16_t* WcoT = (bf16_t*)(ws + WS_WCO); bf16_t* WroT = (bf16_t*)(ws + WS_WRO); bf16_t* WoT = (bf16_t*)(ws + WS_WO); bf16_t* WfiT = (bf16_t*)(ws + WS_WFI);
    bf16_t* WfoT = (bf16_t*)(ws + WS_WFO); bf16_t* WpgT = (bf16_t*)(ws + WS_WPG); bf16_t* WppT = (bf16_t*)(ws + WS_WPP);
    bf16_t* cb = (bf16_t*)(ws + WS_CB); bf16_t* ub = (bf16_t*)(ws + WS_U); bf16_t* qb = (bf16_t*)(ws + WS_Q); bf16_t* kb = (bf16_t*)(ws + WS_K);
    bf16_t* vb = (bf16_t*)(ws + WS_V); bf16_t* sgr = (bf16_t*)(ws + WS_SGR); bf16_t* sgc = (bf16_t*)(ws + WS_SGC);
    bf16_t* sg = (bf16_t*)a.out;
    float* x1 = (float*)(ws + WS_Q); bf16_t* x1b = ub; bf16_t* hid = vb; bf16_t* x2b = cb; bf16_t* ppb = sgc;
    LAS float* scr = (LAS float*)(lds + wave * 16384);

#ifndef PHMASK
#define PHMASK 0xFFFF
#endif
    unsigned* barw = (unsigned*)(ws + 9 * MiB);
    volatile LAS unsigned* MISC = (volatile LAS unsigned*)(lds + 131072 + 320);
    if (bx == 0) for (int i = tid; i < XCD_BAR_WORDS; i += 512) barw[i] = 0u;
    if (tid < 2) MISC[tid] = 0u;
    STAMP(0);
    for (int it = gw; it < (D / 64) * (NIN / 32); it += NGW) transpose_matrix_item<1>(w_in, D, NIN, WinT, nullptr, it, scr, lane);
    for (int m = gw; m < M; m += NGW) {
        const f32x4* xr = (const f32x4*)(x + (size_t)m * D) + lane; const f32x4* gr = (const f32x4*)g_mix + lane;
        f32x4 v[8]; float s = 0.f;
#pragma unroll
        for (int j = 0; j < 8; ++j) { v[j] = xr[64 * j]; s += (v[j].x * v[j].x + v[j].y * v[j].y) + (v[j].z * v[j].z + v[j].w * v[j].w); }
        const float rs = rsqrtf(wave_sum(s) * (1.0f / D) + EPS);
        u32x2* o8 = (u32x2*)(hb + (size_t)m * D) + lane;
#pragma unroll
        for (int j = 0; j < 8; ++j) { const f32x4 gg = gr[64 * j]; u32x2 pk; pk.x = cvtpk(v[j].x * rs * gg.x, v[j].y * rs * gg.y); pk.y = cvtpk(v[j].z * rs * gg.z, v[j].w * rs * gg.w); o8[64 * j] = pk; }
    }
    for (size_t i = (size_t)bx * 512 + tid; i < (size_t)M * PLE / 8; i += (size_t)G * 512) {
        const f32x4 a0 = ((const f32x4*)p)[2 * i], a1 = ((const f32x4*)p)[2 * i + 1]; ((u32x4*)pb)[i] = pack8(a0, a1); }
    grid.sync(); STAMP(1);
    const XcdBarrier xbar = xcd_barrier_post(barw, MISC);

    if (PHMASK & 2) { pg8::Gemm g{hb, WinT, M, NIN, D}; pg8::StaticOrder S; S.init(M, NIN, G, bx);
      EpiInProj E{cb, ub, qb, kb, vb, sg, sgc, sgr};
      pg8::gemm_phase(lds, g, S, E); }
    xcd_barrier(xbar); STAMP(2);

    if (PHMASK & 4) for (int item = bx; item < 256; item += G) { retention_item(lds, qb, kb, vb, item); }
    xcd_barrier(xbar); STAMP(3);

    for (int strip = bx; strip < M / 32; strip += G) {
        const int cgp = tid & 255, rh = tid >> 8, r0 = strip * 32 + rh * 16, c0 = cgp * 8;
        f32x4 w0a = *(const f32x4*)(conv_w + c0), w0b = *(const f32x4*)(conv_w + c0 + 4), w1a = *(const f32x4*)(conv_w + D + c0), w1b = *(const f32x4*)(conv_w + D + c0 + 4),
              w2a = *(const f32x4*)(conv_w + 2 * D + c0), w2b = *(const f32x4*)(conv_w + 2 * D + c0 + 4);
        f32x4 p2a = {0.f, 0.f, 0.f, 0.f}, p2b = p2a, p1a = p2a, p1b = p2a;
        const int s0 = r0 & (SEQ - 1);
        if (s0 >= 2) { unpack8(*(const u32x4*)(ub + (size_t)(r0 - 2) * D + c0), p2a, p2b); unpack8(*(const u32x4*)(ub + (size_t)(r0 - 1) * D + c0), p1a, p1b); }
#pragma unroll 4
        for (int i = 0; i < 16; ++i) { const size_t off = (size_t)(r0 + i) * D + c0; f32x4 ua, ubv, ca, cbv; unpack8(*(const u32x4*)(ub + off), ua, ubv); unpack8(*(const u32x4*)(cb + off), ca, cbv);
            const f32x4 ya = ca * (w0a * p2a + w1a * p1a + w2a * ua), yb = cbv * (w0b * p2b + w1b * p1b + w2b * ubv);
            *(u32x4*)(cb + off) = pack8(ya, yb); p2a = p1a; p2b = p1b; p1a = ua; p1b = ubv; }
    }
    for (int it = gw; it < M * 8; it += NGW) {
        const int row = it >> 3, hh = it & 7; const size_t off = (size_t)row * RV + hh * 512 + lane * 8;
        f32x4 oa, ob, ga, gb; unpack8(*(const u32x4*)(vb + off), oa, ob); unpack8(*(const u32x4*)(sg + off), ga, gb);
        const float mu = wave_sum((oa.x + oa.y) + (oa.z + oa.w) + (ob.x + ob.y) + (ob.z + ob.w)) * (1.0f / 512.0f);
        oa = oa - mu; ob = ob - mu;
        const float var = wave_sum((oa.x * oa.x + oa.y * oa.y) + (oa.z * oa.z + oa.w * oa.w) + (ob.x * ob.x + ob.y * ob.y) + (ob.z * ob.z + ob.w * ob.w)) * (1.0f / 512.0f);
        const float rs = rsqrtf(var + EPS);
        const f32x4 wa = *(const f32x4*)(g_ret + hh * 512 + lane * 8), wb = *(const f32x4*)(g_ret + hh * 512 + lane * 8 + 4);
        *(u32x4*)(vb + off) = pack8(oa * rs * wa * ga, ob * rs * wb * gb);
    }
    {
        constexpr int I_CO = (D / 64) * (D / 32), I_RO = (RV / 64) * (D / 32), I_O = I_CO, I_FI = (D / 64) * (2 * DFF / 32), I_FO = (DFF / 64) * (D / 32), I_PG = I_CO, I_PP = (PLE / 64) * (D / 32);
        constexpr int NIT = I_CO + I_RO + I_O + I_FI + I_FO + I_PG + I_PP;
        for (int it = gw; it < NIT; it += NGW) {
            int r = it;
            if (r < I_CO) { transpose_matrix_item<0>(w_conv_out, D, D, WcoT, nullptr, r, scr, lane); continue; } r -= I_CO;
            if (r < I_RO) { transpose_matrix_item<0>(w_ret_out, RV, D, WroT, nullptr, r, scr, lane); continue; } r -= I_RO;
            if (r < I_O) { transpose_matrix_item<0>(w_o, D, D, WoT, nullptr, r, scr, lane); continue; } r -= I_O;
            if (r < I_FI) { transpose_matrix_item<2>(w_ffn_in, D, 2 * DFF, WfiT, g_ffn, r, scr, lane); continue; } r -= I_FI;
            if (r < I_FO) { transpose_matrix_item<0>(w_ffn_out, DFF, D, WfoT, nullptr, r, scr, lane); continue; } r -= I_FO;
            if (r < I_PG) { transpose_matrix_item<0>(w_ple_gate, D, D, WpgT, g_ple, r, scr, lane); continue; } r -= I_PG;
            transpose_matrix_item<0>(w_ple_proj, PLE, D, WppT, nullptr, r, scr, lane);
        }
    }
    xcd_barrier(xbar); STAMP(4);

    if (PHMASK & 16) { pg8::Gemm g{cb, WcoT, M, D, D}; pg8::StaticOrder S; S.init(M, D, G, bx); EpiGate E{nullptr, sgc, sgc}; pg8::gemm_phase(lds, g, S, E); }
    if (PHMASK & 16) { pg8::Gemm g{vb, WroT, M, D, RV}; pg8::StaticOrder S; S.init(M, D, G, bx); EpiGate E{sgc, sgr, sgc}; pg8::gemm_phase(lds, g, S, E); }
    xcd_barrier(xbar); STAMP(5);

    if (PHMASK & 32) { pg8::Gemm g{sgc, WoT, M, D, D}; pg8::StaticOrder S; S.init(M, D, G, bx); EpiRes E{x, x1, x1b, part1}; pg8::gemm_phase(lds, g, S, E); }
    xcd_barrier(xbar); STAMP(6);

    if (PHMASK & 64) { pg8::Gemm g{x1b, WfiT, M, 2 * DFF, D}; pg8::StaticOrder S; S.init(M, 2 * DFF, G, bx); EpiFfnIn E{part1, hid}; pg8::gemm_phase(lds, g, S, E); }
    xcd_barrier(xbar); STAMP(7);

    if (PHMASK & 128) { pg8::Gemm g{hid, WfoT, M, D, DFF}; pg8::StaticOrder S; S.init(M, D, G, bx); EpiRes E{x1, x1, x2b, part2}; pg8::gemm_phase(lds, g, S, E); }
    xcd_barrier(xbar); STAMP(8);

    if (PHMASK & 256) { pg8::Gemm g{pb, WppT, M, D, PLE}; pg8::StaticOrder S; S.init(M, D, G, bx); EpiPlain E{ppb}; pg8::gemm_phase(lds, g, S, E); }
    if (PHMASK & 512) { pg8::Gemm g{x2b, WpgT, M, D, D}; pg8::StaticOrder S; S.init(M, D, G, bx); EpiPle E{part2, x1, ppb, a.out, part3}; pg8::gemm_phase(lds, g, S, E); }
    xcd_barrier(xbar); STAMP(9);

    for (int m = gw; m < M; m += NGW) {
        float s = (lane < 32) ? part3[(size_t)m * 32 + lane] : 0.f;
        const float rs = rsqrtf(wave_sum(s) * (1.0f / D) + EPS);
        f32x4* xr = (f32x4*)(a.out + (size_t)m * D) + lane; const f32x4* gr = (const f32x4*)g_final + lane;
#pragma unroll
        for (int j = 0; j < 8; ++j) { const f32x4 v = xr[64 * j]; xr[64 * j] = v * rs * gr[64 * j]; }
    }
#if PROBE_LO >= 0
    STAMP(10);
    if (blockIdx.x == 0 && threadIdx.x == 0) { volatile unsigned long long* ts = (volatile unsigned long long*)(a.ws + 8 * MiB);
        const unsigned long long dt = (ts[PROBE_HI] - ts[PROBE_LO]) * PROBE_MULT, t0 = __builtin_amdgcn_s_memrealtime();
        while (__builtin_amdgcn_s_memrealtime() - t0 < dt) __builtin_amdgcn_s_sleep(8); }
#endif
}

extern "C" void kernel_launch(void* const* d_in, const int* in_sizes, int n_in, void* d_out, int out_size, void* d_ws, size_t ws_size, hipStream_t stream) {
    static int grid = 0;
    if (grid == 0) {
        if (n_in != 16 || ws_size < WS_END || out_size != M * D) { fprintf(stderr, "kernel_launch: unexpected shapes (n_in %d, ws %zu, out %d); nothing launched\n", n_in, ws_size, out_size); grid = -1; return; }
        int dev = 0, cus = 0, per_cu = 0;
        (void)hipGetDevice(&dev);
        (void)hipDeviceGetAttribute(&cus, hipDeviceAttributeMultiprocessorCount, dev);
        (void)hipFuncSetAttribute((const void*)mega, hipFuncAttributeMaxDynamicSharedMemorySize, LDS_BYTES);
        (void)hipOccupancyMaxActiveBlocksPerMultiprocessor(&per_cu, (const void*)mega, 512, LDS_BYTES);
        if (per_cu < 1) per_cu = 1;
        grid = cus * per_cu;
        fprintf(stderr, "grid %d (cus %d per_cu %d) ws %zu\n", grid, cus, per_cu, ws_size);
    }
    if (grid < 0) return;
    Args a{};
    for (int i = 0; i < 16; ++i) a.in[i] = (const float*)d_in[i];
    a.out = (float*)d_out; a.ws = (unsigned char*)d_ws;
    void* args[] = {&a};
    hipError_t e = hipLaunchCooperativeKernel((const void*)mega, dim3(grid), dim3(512), args, LDS_BYTES, stream);
    if (e != hipSuccess) fprintf(stderr, "cooperative launch failed: %s (grid %d)\n", hipGetErrorString(e), grid);
}
```
